# Optimizing an MI355X kernel written in HIP

```python
import math
import jax
import jax.numpy as jnp
from jax import lax
import numpy as np

D_MODEL = 1024
BATCH = 16
SEQ = 4096
DEPTH = 1

CTX_LEN = 256
GRID_W = 64
D_MIX = D_MODEL
D_DN = D_MIX // 2
D_ML = D_MIX - D_DN
DN_HEADS = 4
DN_HEAD_DIM = D_DN // DN_HEADS
ML_HEADS = 4
ML_HEAD_DIM = D_ML // ML_HEADS
CONV_K = 5
CHUNK = 64
D_FF = ((8 * D_MODEL // 3 + 255) // 256) * 256
N_MOD = 6
NORM_EPS = 1e-6
DN_SPLITS = (3 * D_DN, 4 * D_DN, 4 * D_DN + 2 * DN_HEADS)
ML_SPLITS = (3 * D_ML, 4 * D_ML, 4 * D_ML + 2 * ML_HEADS)
DN_COLS = 4 * D_DN + 4 * DN_HEADS
ML_COLS = 4 * D_ML + 4 * ML_HEADS
D_IN = DN_COLS + ML_COLS

kernel_name = 'hybrid_gdn_mlstm_diffusion_block'


def rmsnorm(x, gain):
    xf = x.astype(jnp.float32)
    y = xf * lax.rsqrt(jnp.mean(xf * xf, axis=-1, keepdims=True) + NORM_EPS)
    return (y * gain.astype(jnp.float32)).astype(x.dtype)


def l2norm(x):
    return x * lax.rsqrt(jnp.sum(x * x, axis=-1, keepdims=True) + NORM_EPS)


def to_heads(t, n_heads):
    b, s, _ = t.shape
    return t.reshape(b, s, n_heads, -1).transpose(0, 2, 1, 3)


def direction_split(t):
    b, s, _ = t.shape
    return t.reshape(b, s, 2, -1).transpose(2, 0, 3, 1)


def to_col_major(t):
    b, s = t.shape[:2]
    rows = s // GRID_W
    return t.reshape(b, rows, GRID_W, *t.shape[2:]).swapaxes(1, 2).reshape(t.shape)


def to_row_major(t):
    b, s = t.shape[:2]
    rows = s // GRID_W
    return t.reshape(b, GRID_W, rows, *t.shape[2:]).swapaxes(1, 2).reshape(t.shape)


def to_chunks(a):
    b, h, s = a.shape[:3]
    return jnp.moveaxis(a.reshape(b, h, s // CHUNK, CHUNK, *a.shape[3:]), 2, 0)


def from_chunks(a):
    a = jnp.moveaxis(a, 0, 2)
    return a.reshape(a.shape[0], a.shape[1], -1, *a.shape[4:])


def flip_t(a):
    return jnp.flip(a, axis=2)


def short_conv(u, w):
    out = lax.conv_general_dilated(u, w[:, None, :].astype(u.dtype), window_strides=(1,), padding='SAME',
                                   dimension_numbers=('NWC', 'WIO', 'NWC'), feature_group_count=u.shape[-1])
    return jax.nn.silu(out)


def gated_delta_chunked(q, k, v, g, beta, s0, with_output):
    q, k, v, g, beta = map(to_chunks, (q, k, v, g, beta))
    causal = jnp.tril(jnp.ones((CHUNK, CHUNK), bool))
    strict = jnp.tril(jnp.ones((CHUNK, CHUNK), bool), -1)
    G = jnp.cumsum(g, axis=-1)
    decay = jnp.exp(jnp.where(causal, G[..., :, None] - G[..., None, :], -jnp.inf))
    kbeta = k * beta[..., None]
    A = jnp.where(strict, jnp.einsum('nbhik,nbhjk->nbhij', kbeta, k) * decay, 0.0)
    eye_plus_a = A + jnp.eye(CHUNK, dtype=A.dtype)
    W = lax.linalg.triangular_solve(eye_plus_a, kbeta * jnp.exp(G)[..., None], left_side=True, lower=True, unit_diagonal=True)
    U = lax.linalg.triangular_solve(eye_plus_a, v * beta[..., None], left_side=True, lower=True, unit_diagonal=True)

    def body(S, inp):
        qc, kc, wc, uc, Gc, dc = inp
        v_new = uc - jnp.einsum('bhck,bhkv->bhcv', wc, S)
        g_last = Gc[..., -1]
        S_next = S * jnp.exp(g_last)[..., None, None] + jnp.einsum(
            'bhck,bhcv->bhkv', kc * jnp.exp(g_last[..., None] - Gc)[..., None], v_new)
        if with_output:
            scores = jnp.einsum('bhik,bhjk->bhij', qc, kc) * dc
            o = (jnp.einsum('bhck,bhkv->bhcv', qc * jnp.exp(Gc)[..., None], S)
                 + jnp.einsum('bhij,bhjv->bhiv', scores, v_new))
            return S_next, o
        return S_next, None

    s_fin, o = lax.scan(body, s0, (q, k, W, U, G, decay))
    return (from_chunks(o) if with_output else None), s_fin


def mlstm_chunked(q, k, v, ig, lf, state, with_output):
    q, k, v, ig, lf = map(to_chunks, (q, k, v, ig, lf))
    causal = jnp.tril(jnp.ones((CHUNK, CHUNK), bool))

    def body(carry, inp):
        C, n, m = carry
        qc, kc, vc, ic, fc = inp
        b = jnp.cumsum(fc, axis=-1)
        b_last = b[..., -1]
        e = b_last[..., None] - b + ic
        m_next = jnp.maximum(b_last + m, jnp.max(e, axis=-1))
        w_tok = jnp.exp(e - m_next[..., None])
        carry_scale = jnp.exp(b_last + m - m_next)
        C_next = carry_scale[..., None, None] * C + jnp.einsum('bhck,bhcv->bhkv', kc * w_tok[..., None], vc)
        n_next = carry_scale[..., None] * n + jnp.einsum('bhck,bhc->bhk', kc, w_tok)
        if with_output:
            log_d = jnp.where(causal, b[..., :, None] - b[..., None, :] + ic[..., None, :], -jnp.inf)
            inter = b + m[..., None]
            m_i = jnp.maximum(inter, jnp.max(log_d, axis=-1))
            s = jnp.einsum('bhik,bhjk->bhij', qc, kc) * jnp.exp(log_d - m_i[..., None])
            w_inter = jnp.exp(inter - m_i)
            num = w_inter[..., None] * jnp.einsum('bhik,bhkv->bhiv', qc, C) + jnp.einsum('bhij,bhjv->bhiv', s, vc)
            den = w_inter * jnp.einsum('bhik,bhk->bhi', qc, n) + jnp.sum(s, axis=-1)
            h = num / jnp.maximum(jnp.abs(den), jnp.exp(-m_i))[..., None]
            return (C_next, n_next, m_next), h
        return (C_next, n_next, m_next), None

    state_fin, h = lax.scan(body, state, (q, k, v, ig, lf))
    return (from_chunks(h) if with_output else None), state_fin


def run_bidirectional(chunk_fn, shared, per_dir, init_f, init_b, with_output):
    o_f, s_f = chunk_fn(*shared, *(a[0] for a in per_dir), init_f, with_output)
    o_b, s_b = chunk_fn(*(flip_t(a) for a in shared), *(flip_t(a[1]) for a in per_dir), init_b, with_output)
    out = o_f + flip_t(o_b) if with_output else None
    return out, s_f, s_b


def deltanet_group(p_ctx, p_lat, conv_w, a_log, dt_bias, norm_w, need_ctx_out):
    conv_w = conv_w.astype(jnp.float32)
    a = jnp.exp(a_log.astype(jnp.float32))[:, None, :, None]
    dtb = dt_bias.astype(jnp.float32)[:, None, :, None]

    def prep(p):
        qkv, gate, beta_raw, alpha_raw = jnp.split(p, DN_SPLITS, axis=-1)
        q, k, v = [to_heads(t, DN_HEADS) for t in jnp.split(short_conv(qkv, conv_w), 3, axis=-1)]
        q = l2norm(q) * DN_HEAD_DIM ** -0.5
        k = l2norm(k)
        beta = jax.nn.sigmoid(direction_split(beta_raw))
        g = -a * jax.nn.softplus(direction_split(alpha_raw) + dtb)
        return (q, k, v), (g, beta), gate

    def finalize(o, gate):
        b, _, s, _ = o.shape
        o = o.transpose(0, 2, 1, 3)
        y = rmsnorm(o, norm_w) * jax.nn.silu(gate.reshape(b, s, DN_HEADS, DN_HEAD_DIM))
        return y.reshape(b, s, D_DN)

    s0 = jnp.zeros((p_ctx.shape[0], DN_HEADS, DN_HEAD_DIM, DN_HEAD_DIM), jnp.float32)
    sh_c, pd_c, gate_c = prep(p_ctx)
    o_ctx, s_f, s_b = run_bidirectional(gated_delta_chunked, sh_c, pd_c, s0, s0, need_ctx_out)
    sh_l, pd_l, gate_l = prep(p_lat)
    o_lat, _, _ = run_bidirectional(gated_delta_chunked, sh_l, pd_l, s_f, s_b, True)
    y_ctx = finalize(o_ctx, gate_c) if need_ctx_out else None
    return finalize(o_lat, gate_l), y_ctx


def mlstm_group(p_ctx, p_lat, ig_bias, fg_bias, norm_w, need_ctx_out):
    igb = ig_bias.astype(jnp.float32)[:, None, :, None]
    fgb = fg_bias.astype(jnp.float32)[:, None, :, None]

    def prep(p):
        qkv, ogate, ig_raw, fg_raw = jnp.split(p, ML_SPLITS, axis=-1)
        q, k, v = [to_heads(t, ML_HEADS) for t in jnp.split(qkv, 3, axis=-1)]
        k = k * ML_HEAD_DIM ** -0.5
        ig = direction_split(ig_raw) + igb
        lf = jax.nn.log_sigmoid(direction_split(fg_raw) + fgb)
        return (q, k, v), (ig, lf), ogate

    def finalize(h, ogate):
        b, _, s, _ = h.shape
        h = h.transpose(0, 2, 1, 3)
        y = rmsnorm(h, norm_w.reshape(ML_HEADS, ML_HEAD_DIM)).reshape(b, s, D_ML)
        return y * jax.nn.sigmoid(ogate)

    bsz = p_ctx.shape[0]
    st0 = (jnp.zeros((bsz, ML_HEADS, ML_HEAD_DIM, ML_HEAD_DIM), jnp.float32),
           jnp.zeros((bsz, ML_HEADS, ML_HEAD_DIM), jnp.float32),
           jnp.zeros((bsz, ML_HEADS), jnp.float32))
    sh_c, pd_c, og_c = prep(p_ctx)
    h_ctx, st_f, st_b = run_bidirectional(mlstm_chunked, sh_c, pd_c, st0, st0, need_ctx_out)
    sh_l, pd_l, og_l = prep(to_col_major(p_lat))
    h_lat, _, _ = run_bidirectional(mlstm_chunked, sh_l, pd_l, st_f, st_b, True)
    y_ctx = finalize(h_ctx, og_c) if need_ctx_out else None
    return to_row_major(finalize(h_lat, og_l)), y_ctx


def parallel_mixers(h_ctx, h_lat, w_in, dn_conv, dn_a_log, dn_dt_bias, dn_norm,
                    ml_ig_bias, ml_fg_bias, ml_norm, need_ctx_out):
    p_ctx = (h_ctx @ w_in).astype(jnp.float32)
    p_lat = (h_lat @ w_in).astype(jnp.float32)
    dn_lat, dn_ctx = deltanet_group(p_ctx[..., :DN_COLS], p_lat[..., :DN_COLS], dn_conv, dn_a_log,
                                    dn_dt_bias, dn_norm, need_ctx_out)
    ml_lat, ml_ctx = mlstm_group(p_ctx[..., DN_COLS:], p_lat[..., DN_COLS:], ml_ig_bias, ml_fg_bias,
                                 ml_norm, need_ctx_out)
    y_lat = jnp.concatenate([dn_lat, ml_lat], axis=-1).astype(h_lat.dtype)
    y_ctx = jnp.concatenate([dn_ctx, ml_ctx], axis=-1).astype(h_ctx.dtype) if need_ctx_out else None
    return y_lat, y_ctx


def swiglu(h, w_ffn_in, w_ffn_out):
    gate, up = jnp.split(h @ w_ffn_in, 2, axis=-1)
    return (jax.nn.silu(gate) * up) @ w_ffn_out


def setup_inputs(seed: int = 0) -> dict:
    key = jax.random.key(seed)
    ks = jax.random.split(key, 20)
    f32 = jnp.float32

    def nrm(k, shape, scale):
        return jax.random.normal(k, shape, f32) * scale

    def gain(k, shape):
        return 1.0 + 0.02 * jax.random.normal(k, shape, f32)

    dt = jnp.exp(jax.random.uniform(ks[9], (DEPTH, 2, DN_HEADS), f32, math.log(1e-3), math.log(1e-1)))
    return {
        'x': nrm(ks[0], (BATCH, SEQ, D_MODEL), 1.0),
        'c': nrm(ks[1], (BATCH, D_MODEL), 1.0),
        'ctx': nrm(ks[2], (BATCH, CTX_LEN, D_MODEL), 1.0),
        'c_ctx': nrm(ks[3], (D_MODEL,), 1.0),
        'w_mod': nrm(ks[4], (DEPTH, D_MODEL, N_MOD * D_MODEL), 0.5 * D_MODEL ** -0.5),
        'b_mod': nrm(ks[5], (DEPTH, N_MOD * D_MODEL), 0.01),
        'norm1': gain(ks[6], (DEPTH, D_MODEL)),
        'w_in': nrm(ks[7], (DEPTH, D_MODEL, D_IN), D_MODEL ** -0.5),
        'dn_conv': nrm(ks[8], (DEPTH, CONV_K, 3 * D_DN), CONV_K ** -0.5),
        'dn_a_log': jnp.log(jax.random.uniform(ks[10], (DEPTH, 2, DN_HEADS), f32, 1.0, 16.0)),
        'dn_dt_bias': dt + jnp.log(-jnp.expm1(-dt)),
        'dn_norm': gain(ks[11], (DEPTH, DN_HEAD_DIM)),
        'ml_ig_bias': nrm(ks[12], (DEPTH, 2, ML_HEADS), 0.1),
        'ml_fg_bias': jax.random.uniform(ks[13], (DEPTH, 2, ML_HEADS), f32, 3.0, 6.0),
        'ml_norm': gain(ks[14], (DEPTH, D_ML)),
        'w_out': nrm(ks[15], (DEPTH, D_MIX, D_MODEL), D_MIX ** -0.5),
        'norm2': gain(ks[16], (DEPTH, D_MODEL)),
        'w_ffn_in': nrm(ks[17], (DEPTH, D_MODEL, 2 * D_FF), D_MODEL ** -0.5),
        'w_ffn_out': nrm(ks[18], (DEPTH, D_FF, D_MODEL), D_FF ** -0.5),
        'final_norm': gain(ks[19], (D_MODEL,)),
    }


def reference(x, c, ctx, c_ctx, w_mod, b_mod, norm1, w_in, dn_conv, dn_a_log, dn_dt_bias, dn_norm,
              ml_ig_bias, ml_fg_bias, ml_norm, w_out, norm2, w_ffn_in, w_ffn_out, final_norm):
    silu_c = jax.nn.silu(c)
    silu_cc = jax.nn.silu(c_ctx)
    for layer in range(DEPTH):
        need_ctx = layer < DEPTH - 1
        sh1, sc1, g1, sh2, sc2, g2 = jnp.split((silu_c @ w_mod[layer] + b_mod[layer])[:, None, :], N_MOD, axis=-1)
        sh1c, sc1c, g1c, sh2c, sc2c, g2c = jnp.split(silu_cc @ w_mod[layer] + b_mod[layer], N_MOD, axis=-1)
        h_lat = rmsnorm(x, norm1[layer]) * (1 + sc1) + sh1
        h_ctx = rmsnorm(ctx, norm1[layer]) * (1 + sc1c) + sh1c
        y_lat, y_ctx = parallel_mixers(h_ctx, h_lat, w_in[layer], dn_conv[layer], dn_a_log[layer],
                                       dn_dt_bias[layer], dn_norm[layer], ml_ig_bias[layer],
                                       ml_fg_bias[layer], ml_norm[layer], need_ctx)
        x = x + g1 * (y_lat @ w_out[layer])
        x = x + g2 * swiglu(rmsnorm(x, norm2[layer]) * (1 + sc2) + sh2, w_ffn_in[layer], w_ffn_out[layer])
        if need_ctx:
            ctx = ctx + g1c * (y_ctx @ w_out[layer])
            ctx = ctx + g2c * swiglu(rmsnorm(ctx, norm2[layer]) * (1 + sc2c) + sh2c, w_ffn_in[layer], w_ffn_out[layer])
    return rmsnorm(x, final_norm)
```

```cpp
#include <hip/hip_runtime.h>
#include <hip/hip_cooperative_groups.h>
#include <cstdio>
namespace cg = cooperative_groups;

#ifndef N_LAUNCH_PER_PHASE
#define N_LAUNCH_PER_PHASE 0
#endif

#define LAS __attribute__((address_space(3)))
typedef unsigned short bf16_t;
typedef short bf16x8 __attribute__((ext_vector_type(8)));
typedef float f32x4 __attribute__((ext_vector_type(4)));
typedef float f32x2 __attribute__((ext_vector_type(2)));
typedef float f32x16 __attribute__((ext_vector_type(16)));
typedef unsigned u32x4 __attribute__((ext_vector_type(4)));
typedef unsigned u32x2 __attribute__((ext_vector_type(2)));
typedef __bf16 bf16x2_t __attribute__((ext_vector_type(2)));
#define DI __device__ __forceinline__

constexpr int NB = 16, SEQ = 4096, CTXL = 256, DM = 1024, DFF = 2816;
constexpr int NLAT = NB * SEQ;
constexpr int NCTX = NB * CTXL;
constexpr int MTOT = NLAT + NCTX;
constexpr int PW = 4096;
constexpr int P1W = 1536, P2W = 2560;
constexpr int NMODC = 6144;
constexpr float EPS = 1e-6f;

constexpr size_t OFF_WIN  = 0;
constexpr size_t OFF_WG   = OFF_WIN  + (size_t)4096 * 1024 * 2;
constexpr size_t OFF_WOUT = OFF_WG   + (size_t)32 * 1024 * 2;
constexpr size_t OFF_WFF1 = OFF_WOUT + (size_t)1024 * 1024 * 2;
constexpr size_t OFF_WFF2 = OFF_WFF1 + (size_t)5632 * 1024 * 2;
constexpr size_t OFF_MOD  = OFF_WFF2 + (size_t)1024 * 2816 * 2;
constexpr size_t OFF_GRAW = OFF_MOD  + (size_t)17 * 6144 * 4;
constexpr size_t OFF_A    = ((OFF_GRAW + (size_t)MTOT * 32 * 4) + 4095) / 4096 * 4096;
constexpr size_t OFF_P    = OFF_A + (size_t)2 * NLAT * 1024 * 2;
constexpr size_t OFF_BAR  = OFF_P + (size_t)MTOT * PW * 2;
constexpr size_t OFF_X1B  = OFF_BAR + 16384;
constexpr size_t WS_END   = OFF_X1B + (size_t)NLAT * 1024 * 2;

struct Params {
    const float *x, *c, *ctx, *c_ctx, *w_mod, *b_mod, *norm1, *w_in, *dn_conv, *dn_a_log, *dn_dt_bias, *dn_norm,
                *ml_ig_bias, *ml_fg_bias, *ml_norm, *w_out, *norm2, *w_ffn_in, *w_ffn_out, *final_norm;
    float* out; unsigned char* ws;
    int ph_lo, ph_hi;
};

DI unsigned pk2(float a, float b) { f32x2 v = {a, b}; bf16x2_t r = __builtin_convertvector(v, bf16x2_t); return __builtin_bit_cast(unsigned, r); }
DI bf16_t f2bf(float a) { return (bf16_t)(pk2(a, 0.f) & 0xffffu); }
DI float bf2f(bf16_t v) { return __uint_as_float(((unsigned)v) << 16); }
DI float bflo(unsigned u) { return __uint_as_float(u << 16); }
DI float bfhi(unsigned u) { return __uint_as_float(u & 0xffff0000u); }
DI float sigmoidf_(float x) { return __builtin_amdgcn_rcpf(1.f + __expf(-x)); }
DI float siluf_(float x) { return x * __builtin_amdgcn_rcpf(1.f + __expf(-x)); }
DI float softplusf_(float x) { return x > 20.f ? x : log1pf(expf(x)); }
DI float wave_sum(float v) {
#pragma unroll
    for (int o = 1; o < 64; o <<= 1) v += __shfl_xor(v, o);
    return v;
}
#define MFMA32(a, b, c) __builtin_amdgcn_mfma_f32_32x32x16_bf16((a), (b), (c), 0, 0, 0)
DI float fnma_(float a, float x, float acc) { asm("v_fma_f32 %0, -%1, %2, %0" : "+v"(acc) : "v"(a), "v"(x)); return acc; }
DI int crow(int reg, int hh) { return (reg & 3) + 8 * (reg >> 2) + 4 * hh; }
DI bf16x8 pack_step(const f32x16& x, int s) {
    u32x4 p;
    p.x = pk2(x[8 * s + 0], x[8 * s + 1]); p.y = pk2(x[8 * s + 2], x[8 * s + 3]);
    p.z = pk2(x[8 * s + 4], x[8 * s + 5]); p.w = pk2(x[8 * s + 6], x[8 * s + 7]);
    return __builtin_bit_cast(bf16x8, p);
}
DI bf16x8 load_perm(const bf16_t* base, int stride, int row, int kbase, int hh) {
    const bf16_t* p = base + row * stride + kbase + 4 * hh;
    u32x2 lo = *(const u32x2*)p, hi = *(const u32x2*)(p + 8);
    u32x4 v; v.x = lo.x; v.y = lo.y; v.z = hi.x; v.w = hi.y;
    return __builtin_bit_cast(bf16x8, v);
}
DI bf16x8 load_nat(const bf16_t* base, int stride, int row, int k0) { return *(const bf16x8*)(base + row * stride + k0); }

namespace pg8 {
constexpr int BM = 256, BK = 64, HALF = 128, HTB = HALF * BK * 2, STAGE_BYTES = 8 * HTB, NXCD = 8, WGM = 8;
DI int lds_byte(int r, int c) { const int st = (r >> 4) * 2 + (c >> 5), rr = r & 15, cc = c & 31, ob = rr * 64 + cc * 2; return st * 1024 + (ob ^ (((ob >> 9) & 1) << 5)); }
DI void stage_rc(int b, int& R, int& C) { const int st = b / 1024, sb = b % 1024, swz = sb ^ (((sb >> 9) & 1) << 5); R = (st >> 1) * 16 + swz / 64; C = (st & 1) * 32 + (swz % 64) / 2; }
DI int perm32(int rho) { const int n = rho >> 4, i = rho & 15; return 8 * (i >> 2) + 4 * n + (i & 3); }
struct Unit { int pm, pn; };
struct Gemm { const bf16_t* A; const bf16_t* Bt; int M, N, K; };
struct StaticOrder {
    int nM, nN, nwg, G, c;
    DI void init(int M, int N, int G_, int c_) { nM = M / BM; nN = N / BM; nwg = nM * nN; G = G_; c = c_; }
    DI bool next(int i, Unit& u) const {
        const long L = (long)i * G + c; if (L >= nwg) return false;
        int wgid = (int)L; { const int q = nwg / NXCD, r = nwg % NXCD, xcd = wgid % NXCD, off = wgid / NXCD; wgid = (xcd < r ? xcd * (q + 1) : r * (q + 1) + (xcd - r) * q) + off; }
        const int nig = WGM * nN, gid = wgid / nig, fm = gid * WGM, gsz = (nM - fm) < WGM ? (nM - fm) : WGM;
        u.pm = fm + ((wgid % nig) % gsz); u.pn = (wgid % nig) / gsz; return true;
    }
};

template <class Epi>
DI void gemm_phase(LAS unsigned char* lds, const Gemm g, const StaticOrder& S, const Epi& E) {
    const int tid = threadIdx.x, wid = __builtin_amdgcn_readfirstlane(tid >> 6), lane = tid & 63, wr = wid >> 2, wc = wid & 3, fr = lane & 15, fq = lane >> 4;
    const int K = g.K, nt = K / BK;
    unsigned voffA[2], voffB[2];
#pragma unroll
    for (int i = 0; i < 2; ++i) { int R, C; stage_rc(tid * 16 + i * 8192, R, C); const int Rb = Epi::PERM ? ((R & ~31) + perm32(R & 31)) : R;
        voffA[i] = (unsigned)(R * K + C) * 2u; voffB[i] = (unsigned)(Rb * K + C) * 2u; }
    const size_t kstep = (size_t)(BK * 2);
    const size_t hstep = (size_t)HALF * K * 2;
    const size_t tstep = 2 * hstep;
    const unsigned ldsw = (unsigned)wid * 1024u;
    const int aoff = lds_byte(wr * 64 + fr, fq * 8), boff = lds_byte(wc * 32 + fr, fq * 8);
#define PG8_SA(b, h) (((b) * 2 + (h)) * HTB)
#define PG8_SB(b, h) ((4 + (b) * 2 + (h)) * HTB)
#define PG8_STAGE(bufoff, gbase, voff) do { _Pragma("unroll") for (int _i = 0; _i < 2; ++_i) \
        __builtin_amdgcn_global_load_lds((const unsigned*)((const char*)(gbase) + (voff)[_i]), (LAS unsigned*)(lds + (bufoff) + ldsw + _i * 8192), 16, 0, 0); } while (0)
#define PG8_LDA(dst, b, h) do { _Pragma("unroll") for (int m = 0; m < 4; ++m) _Pragma("unroll") for (int k = 0; k < 2; ++k) dst[m][k] = *(const LAS bf16x8*)(lds + PG8_SA(b, h) + aoff + m * 2048 + k * 1024); } while (0)
#define PG8_LDB(dst, b, h) do { _Pragma("unroll") for (int n = 0; n < 2; ++n) _Pragma("unroll") for (int k = 0; k < 2; ++k) dst[n][k] = *(const LAS bf16x8*)(lds + PG8_SB(b, h) + boff + n * 2048 + k * 1024); } while (0)
#define PG8_MMA(ai, bj, At, Bt) do { __builtin_amdgcn_s_setprio(1); _Pragma("unroll") for (int m = 0; m < 4; ++m) _Pragma("unroll") for (int n = 0; n < 2; ++n) _Pragma("unroll") for (int k = 0; k < 2; ++k) \
        acc[ai][bj][m][n] = __builtin_amdgcn_mfma_f32_16x16x32_bf16(Bt[n][k], At[m][k], acc[ai][bj][m][n], 0, 0, 0); __builtin_amdgcn_s_setprio(0); } while (0)
#define PG8_WAIT_V(n) asm volatile("s_waitcnt vmcnt(" #n ")" ::: "memory")
#define PG8_WAIT_L(n) asm volatile("s_waitcnt lgkmcnt(" #n ")" ::: "memory")
#define PG8_BAR __builtin_amdgcn_s_barrier()
#define PG8_SCHED __builtin_amdgcn_sched_barrier(0)
    Unit cur, nxt; int ui = 0;
    if (!S.next(0, cur)) return;
    f32x4 acc[2][2][4][2];
#pragma unroll
    for (int a = 0; a < 2; ++a)
#pragma unroll
        for (int b = 0; b < 2; ++b)
#pragma unroll
            for (int m = 0; m < 4; ++m)
#pragma unroll
                for (int n = 0; n < 2; ++n) acc[a][b][m][n] = (f32x4){0.f, 0.f, 0.f, 0.f};
    bf16x8 At[4][2], B0[2][2], B1[2][2];
    const char* cA = (const char*)g.A + (size_t)cur.pm * tstep; const char* cB = (const char*)g.Bt + (size_t)cur.pn * tstep;
    PG8_STAGE(PG8_SB(0, 0), cB, voffB); PG8_STAGE(PG8_SA(0, 0), cA, voffA); PG8_STAGE(PG8_SB(0, 1), cB + hstep, voffB); PG8_STAGE(PG8_SA(0, 1), cA + hstep, voffA);
    if (wr == 1) PG8_BAR;
    PG8_WAIT_V(4); PG8_BAR;
    PG8_STAGE(PG8_SB(1, 0), cB + kstep, voffB); PG8_STAGE(PG8_SA(1, 0), cA + kstep, voffA); PG8_STAGE(PG8_SB(1, 1), cB + hstep + kstep, voffB);
    PG8_WAIT_V(6); PG8_BAR;
    for (;;) {
        const bool has_next = S.next(ui + 1, nxt);
        const char* nA = has_next ? (const char*)g.A + (size_t)nxt.pm * tstep : cA; const char* nB = has_next ? (const char*)g.Bt + (size_t)nxt.pn * tstep : cB;
        for (int t = 0; t < nt; t += 2) {
            const bool last = (t == nt - 2);
            const char* a1 = cA + (size_t)(t + 1) * kstep;
            const char* a2 = last ? nA : cA + (size_t)(t + 2) * kstep; const char* b2 = last ? nB : cB + (size_t)(t + 2) * kstep;
            const char* a3 = a2 + kstep; const char* b3 = b2 + kstep;
            PG8_LDB(B0, 0, 0); PG8_SCHED; PG8_LDA(At, 0, 0); PG8_STAGE(PG8_SA(1, 1), a1 + hstep, voffA);
            PG8_WAIT_L(8); PG8_BAR; PG8_WAIT_L(0); PG8_MMA(0, 0, At, B0); PG8_BAR; PG8_SCHED;
            PG8_LDB(B1, 0, 1); PG8_STAGE(PG8_SB(0, 0), b2, voffB);
            PG8_BAR; PG8_WAIT_L(0); PG8_MMA(0, 1, At, B1); PG8_BAR;
            PG8_LDA(At, 0, 1); PG8_STAGE(PG8_SA(0, 0), a2, voffA);
            PG8_BAR; PG8_WAIT_L(0); PG8_MMA(1, 0, At, B0); PG8_BAR; PG8_SCHED;
            PG8_STAGE(PG8_SB(0, 1), b2 + hstep, voffB);
            PG8_WAIT_V(6); PG8_BAR; PG8_MMA(1, 1, At, B1); PG8_BAR;
            PG8_LDB(B0, 1, 0); PG8_SCHED; PG8_LDA(At, 1, 0); PG8_STAGE(PG8_SA(0, 1), a2 + hstep, voffA);
            PG8_WAIT_L(8); PG8_BAR; PG8_WAIT_L(0); PG8_MMA(0, 0, At, B0); PG8_BAR; PG8_SCHED;
            PG8_LDB(B1, 1, 1); PG8_STAGE(PG8_SB(1, 0), b3, voffB);
            PG8_BAR; PG8_WAIT_L(0); PG8_MMA(0, 1, At, B1); PG8_BAR;
            PG8_LDA(At, 1, 1); PG8_STAGE(PG8_SA(1, 0), a3, voffA);
            PG8_BAR; PG8_WAIT_L(0); PG8_MMA(1, 0, At, B0); PG8_BAR; PG8_SCHED;
            PG8_STAGE(PG8_SB(1, 1), b3 + hstep, voffB);
            PG8_WAIT_V(6); PG8_BAR; PG8_MMA(1, 1, At, B1); PG8_BAR;
        }
        E(acc, cur, wr, wc, fr, fq);
        if (!has_next) break;
#pragma unroll
        for (int a = 0; a < 2; ++a)
#pragma unroll
            for (int b = 0; b < 2; ++b)
#pragma unroll
                for (int m = 0; m < 4; ++m)
#pragma unroll
                    for (int n = 0; n < 2; ++n) acc[a][b][m][n] = (f32x4){0.f, 0.f, 0.f, 0.f};
        cur = nxt; cA = nA; cB = nB; ++ui;
    }
    PG8_WAIT_V(0);
    if (wr == 0) PG8_BAR;
    PG8_BAR;
#undef PG8_SA
#undef PG8_SB
#undef PG8_STAGE
#undef PG8_LDA
#undef PG8_LDB
#undef PG8_MMA
#undef PG8_WAIT_V
#undef PG8_WAIT_L
#undef PG8_BAR
#undef PG8_SCHED
}

struct EpiBf16 {
    static constexpr bool PERM = true;
    bf16_t* O1; bf16_t* O2;
    DI void operator()(const f32x4 (&acc)[2][2][4][2], const Unit& u, int wr, int wc, int fr, int fq) const {
        const bool first = u.pn < 6; const int ldc = first ? P1W : P2W;
        const int row0 = u.pm * BM + wr * 64 + fr, col0 = (first ? u.pn : u.pn - 6) * BM + wc * 32 + 8 * fq;
        bf16_t* O = first ? O1 : O2;
#pragma unroll
        for (int ai = 0; ai < 2; ++ai)
#pragma unroll
            for (int m = 0; m < 4; ++m) { bf16_t* rowp = O + (size_t)(row0 + ai * HALF + m * 16) * ldc + col0;
#pragma unroll
                for (int bj = 0; bj < 2; ++bj) { const f32x4 v0 = acc[ai][bj][m][0], v1 = acc[ai][bj][m][1];
                    u32x4 w; w.x = pk2(v0[0], v0[1]); w.y = pk2(v0[2], v0[3]); w.z = pk2(v1[0], v1[1]); w.w = pk2(v1[2], v1[3]);
                    *(u32x4*)(rowp + bj * HALF) = w; } }
    }
};
struct EpiSwiglu {
    static constexpr bool PERM = true;
    bf16_t* O;
    DI void operator()(const f32x4 (&acc)[2][2][4][2], const Unit& u, int wr, int wc, int fr, int fq) const {
        const int row0 = u.pm * BM + wr * 64 + fr, col0 = u.pn * HALF + wc * 32 + 8 * fq;
#pragma unroll
        for (int ai = 0; ai < 2; ++ai)
#pragma unroll
            for (int m = 0; m < 4; ++m) { bf16_t* rowp = O + (size_t)(row0 + ai * HALF + m * 16) * DFF + col0;
                f32x4 v0, v1;
#pragma unroll
                for (int j = 0; j < 4; ++j) { v0[j] = siluf_(acc[ai][0][m][0][j]) * acc[ai][1][m][0][j]; v1[j] = siluf_(acc[ai][0][m][1][j]) * acc[ai][1][m][1][j]; }
                u32x4 w; w.x = pk2(v0[0], v0[1]); w.y = pk2(v0[2], v0[3]); w.z = pk2(v1[0], v1[1]); w.w = pk2(v1[2], v1[3]);
                *(u32x4*)rowp = w; }
    }
};
struct EpiRes {
    static constexpr bool PERM = true;
    const float* base; float* out; const float* gate;
    DI void operator()(const f32x4 (&acc)[2][2][4][2], const Unit& u, int wr, int wc, int fr, int fq) const {
        const int row0 = u.pm * BM + wr * 64 + fr, col0 = u.pn * BM + wc * 32 + 8 * fq;
        const float* gp = gate + (size_t)((u.pm * BM) >> 12) * NMODC + col0;
        f32x4 gv[2][2];
#pragma unroll
        for (int bj = 0; bj < 2; ++bj)
#pragma unroll
            for (int n = 0; n < 2; ++n) gv[bj][n] = *(const f32x4*)(gp + bj * HALF + n * 4);
#pragma unroll
        for (int ai = 0; ai < 2; ++ai)
#pragma unroll
            for (int m = 0; m < 4; ++m) { const size_t ro = (size_t)(row0 + ai * HALF + m * 16) * DM + col0;
#pragma unroll
                for (int bj = 0; bj < 2; ++bj)
#pragma unroll
                    for (int n = 0; n < 2; ++n) { const f32x4 xv = *(const f32x4*)(base + ro + bj * HALF + n * 4);
                        *(f32x4*)(out + ro + bj * HALF + n * 4) = xv + gv[bj][n] * acc[ai][bj][m][n]; } }
    }
};
struct EpiResB {
    static constexpr bool PERM = true;
    const float* base; bf16_t* outb; const float* gate;
    DI void operator()(const f32x4 (&acc)[2][2][4][2], const Unit& u, int wr, int wc, int fr, int fq) const {
        const int row0 = u.pm * BM + wr * 64 + fr, col0 = u.pn * BM + wc * 32 + 8 * fq;
        const float* gp = gate + (size_t)((u.pm * BM) >> 12) * NMODC + col0;
        f32x4 gv[2][2];
#pragma unroll
        for (int bj = 0; bj < 2; ++bj)
#pragma unroll
            for (int n = 0; n < 2; ++n) gv[bj][n] = *(const f32x4*)(gp + bj * HALF + n * 4);
#pragma unroll
        for (int ai = 0; ai < 2; ++ai)
#pragma unroll
            for (int m = 0; m < 4; ++m) { const size_t ro = (size_t)(row0 + ai * HALF + m * 16) * DM + col0;
#pragma unroll
                for (int bj = 0; bj < 2; ++bj) {
                    const f32x4 x0 = *(const f32x4*)(base + ro + bj * HALF) + gv[bj][0] * acc[ai][bj][m][0], x1 = *(const f32x4*)(base + ro + bj * HALF + 4) + gv[bj][1] * acc[ai][bj][m][1];
                    u32x4 w; w.x = pk2(x0.x, x0.y); w.y = pk2(x0.z, x0.w); w.z = pk2(x1.x, x1.y); w.w = pk2(x1.z, x1.w);
                    *(u32x4*)(outb + ro + bj * HALF) = w; } }
    }
};
struct EpiResFromB {
    static constexpr bool PERM = true;
    bf16_t* xb; const float* gate;
    DI void operator()(const f32x4 (&acc)[2][2][4][2], const Unit& u, int wr, int wc, int fr, int fq) const {
        const int row0 = u.pm * BM + wr * 64 + fr, col0 = u.pn * BM + wc * 32 + 8 * fq;
        const float* gp = gate + (size_t)((u.pm * BM) >> 12) * NMODC + col0;
        f32x4 gv[2][2];
#pragma unroll
        for (int bj = 0; bj < 2; ++bj)
#pragma unroll
            for (int n = 0; n < 2; ++n) gv[bj][n] = *(const f32x4*)(gp + bj * HALF + n * 4);
#pragma unroll
        for (int ai = 0; ai < 2; ++ai)
#pragma unroll
            for (int m = 0; m < 4; ++m) { const size_t ro = (size_t)(row0 + ai * HALF + m * 16) * DM + col0;
#pragma unroll
                for (int bj = 0; bj < 2; ++bj) {
                    const u32x4 q = *(const u32x4*)(xb + ro + bj * HALF);
                    const f32x4 b0 = {bflo(q.x), bfhi(q.x), bflo(q.y), bfhi(q.y)}, b1 = {bflo(q.z), bfhi(q.z), bflo(q.w), bfhi(q.w)};
                    const f32x4 x0 = b0 + gv[bj][0] * acc[ai][bj][m][0], x1 = b1 + gv[bj][1] * acc[ai][bj][m][1];
                    u32x4 w; w.x = pk2(x0.x, x0.y); w.y = pk2(x0.z, x0.w); w.z = pk2(x1.x, x1.y); w.w = pk2(x1.z, x1.w);
                    *(u32x4*)(xb + ro + bj * HALF) = w; } }
    }
};
}

template <int MAP>
DI void transpose_item(const float* W, int K, int N, unsigned char* ws, float* scr, int item, int lane) {
    const int nblk = N / 32, kb = item / nblk, nb = item % nblk, k0 = 64 * kb, n0 = 32 * nb;
#pragma unroll 8
    for (int i = 0; i < 32; ++i) { const int kk = 2 * i + (lane >> 5); scr[kk * 33 + (lane & 31)] = W[(size_t)(k0 + kk) * N + n0 + (lane & 31)]; }
    __builtin_amdgcn_wave_barrier();
    asm volatile("s_waitcnt lgkmcnt(0)" ::: "memory");
    const int c = lane & 7;
#pragma unroll
    for (int j = 0; j < 4; ++j) {
        const int nl = (lane >> 3) + 8 * j, n = n0 + nl; const float* s = scr + (8 * c) * 33 + nl;
        u32x4 o; o.x = pk2(s[0 * 33], s[1 * 33]); o.y = pk2(s[2 * 33], s[3 * 33]); o.z = pk2(s[4 * 33], s[5 * 33]); o.w = pk2(s[6 * 33], s[7 * 33]);
        bf16_t* dst;
        if (MAP == 0) {
            if (n < 2048) dst = (bf16_t*)(ws + OFF_WIN) + (size_t)n * K;
            else if (n < 2064) dst = (bf16_t*)(ws + OFF_WG) + (size_t)(n - 2048) * K;
            else if (n < 4112) dst = (bf16_t*)(ws + OFF_WIN) + (size_t)(n - 16) * K;
            else dst = (bf16_t*)(ws + OFF_WG) + (size_t)(16 + n - 4112) * K;
        } else if (MAP == 1) {
            dst = (bf16_t*)(ws + OFF_WOUT) + (size_t)n * K;
        } else if (MAP == 2) {
            const int up = n >= DFF, ff = up ? n - DFF : n;
            dst = (bf16_t*)(ws + OFF_WFF1) + (size_t)(256 * (ff >> 7) + 128 * up + (ff & 127)) * K;
        } else {
            dst = (bf16_t*)(ws + OFF_WFF2) + (size_t)n * K;
        }
        *(u32x4*)(dst + k0 + 8 * c) = o;
    }
    __builtin_amdgcn_wave_barrier();
    asm volatile("s_waitcnt lgkmcnt(0)" ::: "memory");
}

DI void phase0(const Params& p, unsigned char* smem) {
    const int tid = threadIdx.x, wave = tid >> 6, lane = tid & 63;
    float* sc = (float*)smem;
    float* red = (float*)(smem + 17 * 1024 * 4);
    float* modp = (float*)(p.ws + OFF_MOD);
    if (blockIdx.x < 192) {
        for (int idx = tid; idx < 17 * 1024; idx += 512) { const float v = idx < 16384 ? p.c[idx] : p.c_ctx[idx - 16384]; sc[idx] = siluf_(v); }
        __syncthreads();
        for (int item = blockIdx.x; item < 192; item += gridDim.x) {
            const int col = item * 32 + (lane & 31), kh = lane >> 5;
            float acc[17];
#pragma unroll
            for (int b = 0; b < 17; ++b) acc[b] = 0.f;
#pragma unroll 4
            for (int kk = 0; kk < 64; ++kk) {
                const int k = 128 * wave + 2 * kk + kh; const float wv = p.w_mod[(size_t)k * NMODC + col];
#pragma unroll
                for (int b = 0; b < 17; ++b) acc[b] += sc[b * 1024 + k] * wv;
            }
#pragma unroll
            for (int b = 0; b < 17; ++b) { acc[b] += __shfl_xor(acc[b], 32); if (lane < 32) red[(wave * 17 + b) * 32 + lane] = acc[b]; }
            __syncthreads();
            for (int idx = tid; idx < 17 * 32; idx += 512) { const int b = idx >> 5, cc = idx & 31; float s = p.b_mod[item * 32 + cc];
#pragma unroll
                for (int w = 0; w < 8; ++w) s += red[(w * 17 + b) * 32 + cc];
                modp[b * NMODC + item * 32 + cc] = s; }
            __syncthreads();
        }
    }
    __syncthreads();
    float* scr = (float*)(smem + wave * 8704);
    constexpr int I0 = 16 * 129, I1 = 16 * 32, I2 = 16 * 176, I3 = 44 * 32;
    const int gw = blockIdx.x * 8 + wave, NGW = gridDim.x * 8;
    for (int it = gw; it < I0 + I1 + I2 + I3; it += NGW) {
        int r = it;
        if (r < I0) { transpose_item<0>(p.w_in, 1024, 4128, p.ws, scr, r, lane); continue; } r -= I0;
        if (r < I1) { transpose_item<1>(p.w_out, 1024, 1024, p.ws, scr, r, lane); continue; } r -= I1;
        if (r < I2) { transpose_item<2>(p.w_ffn_in, 1024, 5632, p.ws, scr, r, lane); continue; } r -= I2;
        transpose_item<3>(p.w_ffn_out, 2816, 1024, p.ws, scr, r, lane);
    }
}

template <int MODE>
DI void norm_rows(const Params& p) {
    const int wave = threadIdx.x >> 6, lane = threadIdx.x & 63;
    const int gw = blockIdx.x * 8 + wave, NGW = gridDim.x * 8;
    const int nrows = MODE == 0 ? MTOT : NLAT;
    const float* modp = (const float*)(p.ws + OFF_MOD);
    const float* gain = MODE == 0 ? p.norm1 : (MODE == 1 ? p.norm2 : p.final_norm);
    f32x4 gn[4];
#pragma unroll
    for (int j = 0; j < 4; ++j) gn[j] = *(const f32x4*)(gain + 4 * lane + 256 * j);
    for (int row0 = gw; row0 < nrows; row0 += 2 * NGW) {
        const float* src[2]; int mb[2]; f32x4 v[2][4]; float s[2];
#pragma unroll
        for (int u = 0; u < 2; ++u) {
            const int row = row0 + u * NGW < nrows ? row0 + u * NGW : row0;
            if (MODE == 0) { if (row < NLAT) { src[u] = p.x + (size_t)row * DM; mb[u] = row >> 12; } else { src[u] = p.ctx + (size_t)(row - NLAT) * DM; mb[u] = 16; } }
            else { src[u] = p.out + (size_t)row * DM; mb[u] = row >> 12; }
#pragma unroll
            for (int j = 0; j < 4; ++j) v[u][j] = *(const f32x4*)(src[u] + 4 * lane + 256 * j);
        }
#pragma unroll
        for (int u = 0; u < 2; ++u) {
            const int row = row0 + u * NGW;
            if (row >= nrows) break;
            s[u] = 0.f;
#pragma unroll
            for (int j = 0; j < 4; ++j) s[u] += (v[u][j].x * v[u][j].x + v[u][j].y * v[u][j].y) + (v[u][j].z * v[u][j].z + v[u][j].w * v[u][j].w);
            const float rstd = rsqrtf(wave_sum(s[u]) * (1.f / DM) + EPS);
            if (MODE == 2) {
                float* dst = p.out + (size_t)row * DM;
#pragma unroll
                for (int j = 0; j < 4; ++j) *(f32x4*)(dst + 4 * lane + 256 * j) = v[u][j] * rstd * gn[j];
            } else {
                const float* mrow = modp + (size_t)mb[u] * NMODC + (MODE == 0 ? 0 : 3072);
                bf16_t* dst = (bf16_t*)(p.ws + OFF_A) + (MODE == 0 ? (size_t)0 : (size_t)NLAT * 1024) + (size_t)row * DM;
#pragma unroll
                for (int j = 0; j < 4; ++j) {
                    const f32x4 sh = *(const f32x4*)(mrow + 4 * lane + 256 * j), scl = *(const f32x4*)(mrow + 1024 + 4 * lane + 256 * j);
                    const f32x4 y = (v[u][j] * rstd * gn[j]) * (scl + 1.f) + sh;
                    u32x2 o; o.x = pk2(y.x, y.y); o.y = pk2(y.z, y.w);
                    *(u32x2*)(dst + 4 * lane + 256 * j) = o;
                }
            }
        }
    }
}

DI void norm_rows_b(const Params& p) {
    const int wave = threadIdx.x >> 6, lane = threadIdx.x & 63;
    const int gw = blockIdx.x * 8 + wave, NGW = gridDim.x * 8;
    const float* modp = (const float*)(p.ws + OFF_MOD);
    const bf16_t* X1 = (const bf16_t*)(p.ws + OFF_X1B); bf16_t* H2 = (bf16_t*)(p.ws + OFF_A) + (size_t)NLAT * 1024;
    f32x4 gn[2][2];
#pragma unroll
    for (int j = 0; j < 2; ++j) { gn[j][0] = *(const f32x4*)(p.norm2 + 8 * lane + 512 * j); gn[j][1] = *(const f32x4*)(p.norm2 + 8 * lane + 512 * j + 4); }
    for (int row0 = gw; row0 < NLAT; row0 += 4 * NGW) {
        u32x4 v[4][2];
#pragma unroll
        for (int u = 0; u < 4; ++u)
#pragma unroll
            for (int j = 0; j < 2; ++j) v[u][j] = *(const u32x4*)(X1 + (size_t)(row0 + u * NGW) * DM + 8 * lane + 512 * j);
#pragma unroll
        for (int u = 0; u < 4; ++u) {
            const int row = row0 + u * NGW;
            float f[2][8]; float s = 0.f;
#pragma unroll
            for (int j = 0; j < 2; ++j) { const u32x4 q = v[u][j];
                f[j][0] = bflo(q.x); f[j][1] = bfhi(q.x); f[j][2] = bflo(q.y); f[j][3] = bfhi(q.y); f[j][4] = bflo(q.z); f[j][5] = bfhi(q.z); f[j][6] = bflo(q.w); f[j][7] = bfhi(q.w);
#pragma unroll
                for (int e = 0; e < 8; ++e) s += f[j][e] * f[j][e]; }
            const float rstd = rsqrtf(wave_sum(s) * (1.f / DM) + EPS);
            const float* mrow = modp + (size_t)(row >> 12) * NMODC + 3072;
#pragma unroll
            for (int j = 0; j < 2; ++j) {
                const f32x4 sh0 = *(const f32x4*)(mrow + 8 * lane + 512 * j), sh1 = *(const f32x4*)(mrow + 8 * lane + 512 * j + 4);
                const f32x4 sc0 = *(const f32x4*)(mrow + 1024 + 8 * lane + 512 * j), sc1 = *(const f32x4*)(mrow + 1024 + 8 * lane + 512 * j + 4);
                const f32x4 x0 = {f[j][0], f[j][1], f[j][2], f[j][3]}, x1 = {f[j][4], f[j][5], f[j][6], f[j][7]};
                const f32x4 y0 = (x0 * rstd * gn[j][0]) * (sc0 + 1.f) + sh0, y1 = (x1 * rstd * gn[j][1]) * (sc1 + 1.f) + sh1;
                u32x4 o; o.x = pk2(y0.x, y0.y); o.y = pk2(y0.z, y0.w); o.z = pk2(y1.x, y1.y); o.w = pk2(y1.z, y1.w);
                *(u32x4*)(H2 + (size_t)row * DM + 8 * lane + 512 * j) = o;
            }
        }
    }
}

DI void final_norm_b(const Params& p) {
    const int wave = threadIdx.x >> 6, lane = threadIdx.x & 63;
    const int gw = blockIdx.x * 8 + wave, NGW = gridDim.x * 8;
    const bf16_t* X2 = (const bf16_t*)(p.ws + OFF_X1B);
    f32x4 gn[4];
#pragma unroll
    for (int j = 0; j < 4; ++j) gn[j] = *(const f32x4*)(p.final_norm + 4 * lane + 256 * j);
    for (int row0 = gw; row0 < NLAT; row0 += 4 * NGW) {
        u32x2 v[4][4];
#pragma unroll
        for (int u = 0; u < 4; ++u)
#pragma unroll
            for (int j = 0; j < 4; ++j) v[u][j] = *(const u32x2*)(X2 + (size_t)(row0 + u * NGW) * DM + 4 * lane + 256 * j);
#pragma unroll
        for (int u = 0; u < 4; ++u) {
            const int row = row0 + u * NGW;
            f32x4 f[4]; float s = 0.f;
#pragma unroll
            for (int j = 0; j < 4; ++j) { const u32x2 q = v[u][j]; f[j] = (f32x4){bflo(q.x), bfhi(q.x), bflo(q.y), bfhi(q.y)};
                s += (f[j].x * f[j].x + f[j].y * f[j].y) + (f[j].z * f[j].z + f[j].w * f[j].w); }
            const float rstd = rsqrtf(wave_sum(s) * (1.f / DM) + EPS);
            float* dst = p.out + (size_t)row * DM + 4 * lane;
#pragma unroll
            for (int j = 0; j < 4; ++j) *(f32x4*)(dst + 256 * j) = f[j] * rstd * gn[j];
        }
    }
}

DI void gates_gemm(const Params& p) {
    const int wave = threadIdx.x >> 6, lane = threadIdx.x & 63, r = lane & 31, hh = lane >> 5;
    const int gw = blockIdx.x * 8 + wave, NGW = gridDim.x * 8;
    const bf16_t* H = (const bf16_t*)(p.ws + OFF_A); const bf16_t* WG = (const bf16_t*)(p.ws + OFF_WG);
    float* graw = (float*)(p.ws + OFF_GRAW);
    for (int rg = gw; rg < MTOT / 32; rg += NGW) {
        f32x16 acc; for (int i = 0; i < 16; ++i) acc[i] = 0.f;
        const bf16_t* ap = H + (size_t)(32 * rg + r) * DM + 8 * hh; const bf16_t* bp = WG + (size_t)r * DM + 8 * hh;
#pragma unroll 8
        for (int s = 0; s < 64; ++s) { const bf16x8 a = *(const bf16x8*)(ap + 16 * s), b = *(const bf16x8*)(bp + 16 * s); acc = MFMA32(a, b, acc); }
#pragma unroll
        for (int i = 0; i < 16; ++i) graw[(size_t)(32 * rg + crow(i, hh)) * 32 + r] = acc[i];
    }
}

DI void dn_conv_phase(const Params& p) {
    const int wave = threadIdx.x >> 6, lane = threadIdx.x & 63;
    const int gw = blockIdx.x * 8 + wave, NGW = gridDim.x * 8;
    const bf16_t* P = (const bf16_t*)(p.ws + OFF_P); bf16_t* QKV = (bf16_t*)p.out;
    constexpr int SEG = 16;
    for (int item = gw; item < (MTOT / SEG) * 3; item += NGW) {
        const int seg = item / 3, part = item - seg * 3;
        const int row0 = seg * SEG; const int L = row0 < NLAT ? SEQ : CTXL; const int t0 = (row0 < NLAT ? row0 : row0 - NLAT) & (L - 1);
        const int ch = 8 * (lane + 64 * part);
        f32x2 w[5][4];
#pragma unroll
        for (int j = 0; j < 5; ++j) { const f32x4 a = *(const f32x4*)(p.dn_conv + j * 1536 + ch), b = *(const f32x4*)(p.dn_conv + j * 1536 + ch + 4);
            w[j][0] = (f32x2){a.x, a.y}; w[j][1] = (f32x2){a.z, a.w}; w[j][2] = (f32x2){b.x, b.y}; w[j][3] = (f32x2){b.z, b.w}; }
        const bf16_t* src = P + (size_t)row0 * P1W + ch;
        const u32x4 zero = {0u, 0u, 0u, 0u};
        u32x4 rows[SEG + 4];
#pragma unroll
        for (int q = 0; q < SEG + 4; ++q) { const int t = t0 + q - 2; rows[q] = (t >= 0 && t < L) ? *(const u32x4*)(src + (ptrdiff_t)(q - 2) * P1W) : zero; }
        f32x2 ring[5][4];
#pragma unroll
        for (int q = 0; q < 4; ++q) { const u32x4 u = rows[q];
            ring[q][0] = (f32x2){bflo(u.x), bfhi(u.x)}; ring[q][1] = (f32x2){bflo(u.y), bfhi(u.y)}; ring[q][2] = (f32x2){bflo(u.z), bfhi(u.z)}; ring[q][3] = (f32x2){bflo(u.w), bfhi(u.w)}; }
#pragma unroll
        for (int tt = 0; tt < SEG; ++tt) {
            { const u32x4 u = rows[tt + 4]; const int sl = (tt + 4) % 5;
              ring[sl][0] = (f32x2){bflo(u.x), bfhi(u.x)}; ring[sl][1] = (f32x2){bflo(u.y), bfhi(u.y)}; ring[sl][2] = (f32x2){bflo(u.z), bfhi(u.z)}; ring[sl][3] = (f32x2){bflo(u.w), bfhi(u.w)}; }
            f32x2 o2[4];
#pragma unroll
            for (int e = 0; e < 4; ++e) o2[e] = w[0][e] * ring[tt % 5][e];
#pragma unroll
            for (int j = 1; j < 5; ++j)
#pragma unroll
                for (int e = 0; e < 4; ++e) o2[e] += w[j][e] * ring[(tt + j) % 5][e];
            float o[8];
#pragma unroll
            for (int e = 0; e < 4; ++e) { o[2 * e] = siluf_(o2[e].x); o[2 * e + 1] = siluf_(o2[e].y); }
            if (part < 2) {
                float ss = 0.f;
#pragma unroll
                for (int e = 0; e < 8; ++e) ss += o[e] * o[e];
                ss += __shfl_xor(ss, 1); ss += __shfl_xor(ss, 2); ss += __shfl_xor(ss, 4); ss += __shfl_xor(ss, 8);
                const float sc = rsqrtf(ss + EPS) * (part == 0 ? 0.08838834764831845f : 1.f);
#pragma unroll
                for (int e = 0; e < 8; ++e) o[e] *= sc;
            }
            u32x4 ov; ov.x = pk2(o[0], o[1]); ov.y = pk2(o[2], o[3]); ov.z = pk2(o[4], o[5]); ov.w = pk2(o[6], o[7]);
            *(u32x4*)(QKV + (size_t)(row0 + tt) * 1536 + ch) = ov;
        }
    }
}

DI int scan_row(int type, int dir, int b, int seg, int chunk, int i) {
    const int s = chunk * 64 + i;
    if (seg == 0) { const int pos = dir ? 255 - s : s; return NLAT + b * CTXL + pos; }
    const int pos = dir ? 4095 - s : s;
    const int tok = type ? ((pos & 63) * 64 + (pos >> 6)) : pos;
    return b * SEQ + tok;
}
constexpr int LQ = 0, LK = 17408, LV = 34816, LW = 52224, LKT = 69632, LPM = 88064, LAM = 97280, LU = 114688, LSM = 148480;
constexpr int SCAN_LDS = 156672;
constexpr int ST = 136, STT = 72;

#define LDS_BARRIER() do { asm volatile("s_waitcnt lgkmcnt(0)" ::: "memory"); __builtin_amdgcn_s_barrier(); asm volatile("" ::: "memory"); } while (0)
constexpr int DQ = 0, DK = 17408, DVW = 34816, DKT = 52224, DVT = 70656, DP = 89088, DAD = 98304, DA10 = 107520, DT00 = 110080, DT11 = 112640, DSM = 115200, DSM2 = 117248, DM1 = 119296, DM2T = 124416, DM3 = 129536;
static_assert(DM3 + 5120 <= SCAN_LDS, "scan LDS");
template <bool CONS>
DI void dn_chain_role(const Params& p, unsigned char* smem, int dir, int b, int h) {
    const int tid0 = threadIdx.x, wave = __builtin_amdgcn_readfirstlane(tid0 >> 6), lane0 = tid0 & 63;
    bf16_t* sQ = (bf16_t*)(smem + DQ); bf16_t* sK = (bf16_t*)(smem + DK); bf16_t* sV = (bf16_t*)(smem + DVW);
    bf16_t* sKT = (bf16_t*)(smem + DKT); bf16_t* sVT = (bf16_t*)(smem + DVT); bf16_t* sP = (bf16_t*)(smem + DP);
    float* sAd = (float*)(smem + DAD); bf16_t* sA10 = (bf16_t*)(smem + DA10); bf16_t* sT00 = (bf16_t*)(smem + DT00); bf16_t* sT11 = (bf16_t*)(smem + DT11);
    bf16_t* sM1 = (bf16_t*)(smem + DM1);
    const bf16_t* QKV = (const bf16_t*)p.out; const float* graw = (const float*)(p.ws + OFF_GRAW);
    bf16_t* O = (bf16_t*)(p.ws + OFF_A) + (size_t)dir * NLAT * 1024;
    const float a_coef = expf(p.dn_a_log[dir * 4 + h]), dtb = p.dn_dt_bias[dir * 4 + h];
    f32x16 S[4];
    if (CONS) {
#pragma unroll
        for (int kt = 0; kt < 4; ++kt) for (int i = 0; i < 16; ++i) S[kt][i] = 0.f;
    }
    for (int i = tid0; i < (2560 * 2) / 4; i += 512) ((unsigned*)sT00)[i] = 0u;
    for (int i = tid0; i < (2560 * 6) / 4; i += 512) ((unsigned*)sM1)[i] = 0u;
    for (int i = tid0; i < 9216 / 4; i += 512) ((unsigned*)sP)[i] = 0u;
    u32x4 pq[4], pk[4], pv[4]; float pbr = 0.f, par = 0.f; int prow = 0;
    if (!CONS) {
#pragma unroll
        for (int it = 0; it < 4; ++it) {
            const int idx = tid0 - 256 + 256 * it, i = idx >> 4, c8 = idx & 15;
            const bf16_t* src = QKV + (size_t)scan_row(0, dir, b, 0, 0, i) * 1536 + h * 128 + c8 * 8;
            pq[it] = *(const u32x4*)src; pk[it] = *(const u32x4*)(src + 512); pv[it] = *(const u32x4*)(src + 1024);
        }
    }
    if (!CONS && wave == 5) { prow = scan_row(0, dir, b, 0, 0, lane0); pbr = graw[(size_t)prow * 32 + dir * 4 + h]; par = graw[(size_t)prow * 32 + 8 + dir * 4 + h]; }
    __syncthreads();

    for (int ck = 0; ck < 68; ++ck) {
        int lane = lane0; asm volatile("" : "+v"(lane));
        const int tid = (wave << 6) | lane, r = lane & 31, hh = lane >> 5;
        const int seg = ck >= 4 ? 1 : 0;
        float* sG = (float*)(smem + ((ck & 1) ? DSM2 : DSM)); float* sBeta = sG + 64; float* sEG = sG + 128; float* sDL = sG + 192; int* sRow = (int*)(sG + 320);
        if (!CONS) {
#pragma unroll
            for (int it = 0; it < 4; ++it) {
                const int idx = tid - 256 + 256 * it, i = idx >> 4, c8 = idx & 15;
                *(u32x4*)(sQ + i * ST + c8 * 8) = pq[it]; *(u32x4*)(sK + i * ST + c8 * 8) = pk[it]; *(u32x4*)(sV + i * ST + c8 * 8) = pv[it];
            }
        }
        if (!CONS && wave == 5) {
            const float beta = sigmoidf_(pbr), g = -a_coef * softplusf_(par + dtb);
            float G = g;
#pragma unroll
            for (int o = 1; o < 64; o <<= 1) { const float t = __shfl_up(G, o); if (lane >= o) G += t; }
            const float Gl = __shfl(G, 63), eG = expf(G);
            sG[lane] = G * 1.4426950408889634f; sBeta[lane] = beta; sEG[lane] = eG; sDL[lane] = expf(Gl - G); sRow[lane] = prow;
        }
        if (!CONS && ck + 1 < 68) {
            const int nseg = (ck + 1) >= 4 ? 1 : 0, nchunk = nseg ? ck + 1 - 4 : ck + 1;
#pragma unroll
            for (int it = 0; it < 4; ++it) {
                const int idx = tid - 256 + 256 * it, i = idx >> 4, c8 = idx & 15;
                const bf16_t* src = QKV + (size_t)scan_row(0, dir, b, nseg, nchunk, i) * 1536 + h * 128 + c8 * 8;
                pq[it] = *(const u32x4*)src; pk[it] = *(const u32x4*)(src + 512); pv[it] = *(const u32x4*)(src + 1024);
            }
            if (!CONS && wave == 5) { prow = scan_row(0, dir, b, nseg, nchunk, lane); pbr = graw[(size_t)prow * 32 + dir * 4 + h]; par = graw[(size_t)prow * 32 + 8 + dir * 4 + h]; }
        }
        LDS_BARRIER();
        if ((CONS && (wave == 1 || wave == 3)) || (!CONS && (wave == 5 || wave == 7))) {
            const bool isA10 = CONS && wave == 1;
            const int w3 = CONS ? 1 : (wave == 5 ? 0 : 2), ti = (w3 + 1) >> 1, tj = w3 >> 1;
            const bf16_t* am = isA10 ? sK : sQ;
            f32x16 acc; for (int i = 0; i < 16; ++i) acc[i] = 0.f;
#pragma unroll
            for (int s = 0; s < 8; ++s) { const bf16x8 a = load_nat(am, ST, 32 * ti + r, 16 * s + 8 * hh), bb = load_nat(sK, ST, 32 * tj + r, 16 * s + 8 * hh); acc = MFMA32(a, bb, acc); }
            const int j = 32 * tj + r; const float Gj = sG[j];
            if (isA10) {
#pragma unroll
                for (int g4 = 0; g4 < 4; ++g4) { const int il0 = 8 * g4 + 4 * hh; const f32x4 gi = *(const f32x4*)(sG + 32 + il0), bi = *(const f32x4*)(sBeta + 32 + il0);
#pragma unroll
                    for (int t = 0; t < 4; ++t) sA10[(il0 + t) * 40 + r] = f2bf(acc[4 * g4 + t] * bi[t] * __builtin_amdgcn_exp2f(gi[t] - Gj)); }
            } else {
#pragma unroll
                for (int g4 = 0; g4 < 4; ++g4) { const int i0 = 32 * ti + 8 * g4 + 4 * hh; const f32x4 gi = *(const f32x4*)(sG + i0);
#pragma unroll
                    for (int t = 0; t < 4; ++t) sP[(i0 + t) * STT + j] = f2bf(i0 + t >= j ? acc[4 * g4 + t] * __builtin_amdgcn_exp2f(gi[t] - Gj) : 0.f); }
            }
        }
        if (wave != 4 && wave != 6) {
            const int tq = (wave < 4 ? wave : (wave == 5 ? 4 : 5)) * 64 + lane;
#pragma unroll
            for (int it = 0; it < 3; ++it) {
                const int item = tq + 384 * it;
                if (item < 1024) {
                    const int m = item >> 9, rem = item & 511, i2 = rem & 31, c8 = rem >> 5;
                    const bf16_t* srcp = (m ? sV : sK) + (2 * i2) * ST + c8 * 8;
                    const u32x4 a = *(const u32x4*)srcp, bq = *(const u32x4*)(srcp + ST);
                    unsigned* d = (unsigned*)((m ? sVT : sKT) + (8 * c8) * STT) + i2;
                    d[0 * (STT / 2)] = __builtin_amdgcn_perm(bq.x, a.x, 0x05040100u); d[1 * (STT / 2)] = __builtin_amdgcn_perm(bq.x, a.x, 0x07060302u);
                    d[2 * (STT / 2)] = __builtin_amdgcn_perm(bq.y, a.y, 0x05040100u); d[3 * (STT / 2)] = __builtin_amdgcn_perm(bq.y, a.y, 0x07060302u);
                    d[4 * (STT / 2)] = __builtin_amdgcn_perm(bq.z, a.z, 0x05040100u); d[5 * (STT / 2)] = __builtin_amdgcn_perm(bq.z, a.z, 0x07060302u);
                    d[6 * (STT / 2)] = __builtin_amdgcn_perm(bq.w, a.w, 0x05040100u); d[7 * (STT / 2)] = __builtin_amdgcn_perm(bq.w, a.w, 0x07060302u);
                }
            }
        }
        f32x16 o[2], ks[2];
        if (CONS) {
#pragma unroll
            for (int mi = 0; mi < 2; ++mi) for (int i = 0; i < 16; ++i) { o[mi][i] = 0.f; ks[mi][i] = 0.f; }
#pragma unroll
            for (int kt = 0; kt < 4; ++kt)
#pragma unroll
                for (int s = 0; s < 2; ++s) { const bf16x8 bf = pack_step(S[kt], s);
#pragma unroll
                    for (int mi = 0; mi < 2; ++mi) { o[mi] = MFMA32(load_perm(sQ, ST, 32 * mi + r, 32 * kt + 16 * s, hh), bf, o[mi]);
                                                     ks[mi] = MFMA32(load_perm(sK, ST, 32 * mi + r, 32 * kt + 16 * s, hh), bf, ks[mi]); } }
        } else if (wave == 4 || wave == 6) {
            const int blk = wave == 4 ? 0 : 1;
            bf16_t* sM1b = (bf16_t*)(smem + DM1 + 2560 * blk); bf16_t* sM2Tb = (bf16_t*)(smem + DM2T + 2560 * blk); bf16_t* sM3b = (bf16_t*)(smem + DM3 + 2560 * blk);
            bf16_t* Tb = blk ? sT11 : sT00;
            {
                f32x16 acc; for (int i = 0; i < 16; ++i) acc[i] = 0.f;
#pragma unroll
                for (int s = 0; s < 8; ++s) { const bf16x8 a = load_nat(sK, ST, 32 * blk + r, 16 * s + 8 * hh); acc = MFMA32(a, a, acc); }
                const float Gj = sG[32 * blk + r];
                const int m1col = r < 16 ? r : 32 + (r & 7);
#pragma unroll
                for (int g4 = 0; g4 < 4; ++g4) { const int il0 = 8 * g4 + 4 * hh; const f32x4 gi = *(const f32x4*)(sG + 32 * blk + il0), bi = *(const f32x4*)(sBeta + 32 * blk + il0);
#pragma unroll
                    for (int t = 0; t < 4; ++t) { const int il = il0 + t; const float v = il > r ? acc[4 * g4 + t] * bi[t] * __builtin_amdgcn_exp2f(gi[t] - Gj) : 0.f;
                        sAd[(blk * 32 + il) * 36 + r] = v;
                        if (g4 >= 2) sM1b[(il - 16) * 40 + m1col] = f2bf(v); } }
            }
            asm volatile("s_waitcnt lgkmcnt(0)" ::: "memory");
            __builtin_amdgcn_wave_barrier();
            const int sub = (lane >> 4) & 1, c = lane & 15;
            const float* Ab = sAd + (blk * 32 + 16 * sub) * 36 + 16 * sub;
            f32x4 ar[16][4];
#pragma unroll
            for (int i = 1; i < 16; ++i)
#pragma unroll
                for (int q = 0; q < (i + 3) / 4; ++q) ar[i][q] = *(const f32x4*)(Ab + i * 36 + 4 * q);
            float x[16];
#pragma unroll
            for (int i = 0; i < 16; ++i) {
                float acc = (i == c) ? 1.f : 0.f;
#pragma unroll
                for (int j = 0; j < i; ++j) acc = fnma_(ar[i][j >> 2][j & 3], x[j], acc);
                x[i] = acc;
            }
            { bf16_t* Tq = Tb + (16 * sub) * 40 + 16 * sub + c;
#pragma unroll
              for (int i = 0; i < 16; ++i) Tq[i * 40] = f2bf(x[i]); }
            if (sub == 0) {
                u32x4 xl, xh;
                xl.x = pk2(x[0], x[1]); xl.y = pk2(x[2], x[3]); xl.z = pk2(x[4], x[5]); xl.w = pk2(x[6], x[7]);
                xh.x = pk2(x[8], x[9]); xh.y = pk2(x[10], x[11]); xh.z = pk2(x[12], x[13]); xh.w = pk2(x[14], x[15]);
                *(u32x4*)(sM2Tb + c * 40) = xl; *(u32x4*)(sM2Tb + c * 40 + 8) = xh;
            } else {
#pragma unroll
                for (int i = 0; i < 16; ++i) sM3b[i * 40 + c] = f2bf(x[i]);
            }
            asm volatile("s_waitcnt lgkmcnt(0)" ::: "memory");
            __builtin_amdgcn_wave_barrier();
            f32x16 X1; for (int i = 0; i < 16; ++i) X1[i] = 0.f;
            X1 = MFMA32(load_nat(sM1b, 40, r, 8 * hh), load_nat(sM2Tb, 40, r, 8 * hh), X1);
            f32x16 L1; for (int i = 0; i < 16; ++i) L1[i] = 0.f;
            L1 = MFMA32(load_perm(sM3b, 40, r, 0, hh), pack_step(X1, 0), L1);
            if (r < 16) {
#pragma unroll
                for (int t = 0; t < 8; ++t) Tb[(16 + crow(t, hh)) * 40 + r] = f2bf(-L1[t]);
            }
        }
        LDS_BARRIER();
        if (CONS) {
            f32x16 R[2];
#pragma unroll
            for (int mi = 0; mi < 2; ++mi)
#pragma unroll
                for (int g4 = 0; g4 < 4; ++g4) {
                    const int j0 = 32 * mi + 8 * g4 + 4 * hh;
                    const f32x4 be = *(const f32x4*)(sBeta + j0), eg = *(const f32x4*)(sEG + j0);
                    const u32x2 vv = *(const u32x2*)(sVT + (32 * wave + r) * STT + j0);
                    const float v0 = bflo(vv.x), v1 = bfhi(vv.x), v2 = bflo(vv.y), v3 = bfhi(vv.y);
                    R[mi][4 * g4 + 0] = be.x * (v0 - eg.x * ks[mi][4 * g4 + 0]); R[mi][4 * g4 + 1] = be.y * (v1 - eg.y * ks[mi][4 * g4 + 1]);
                    R[mi][4 * g4 + 2] = be.z * (v2 - eg.z * ks[mi][4 * g4 + 2]); R[mi][4 * g4 + 3] = be.w * (v3 - eg.w * ks[mi][4 * g4 + 3]);
                    o[mi][4 * g4 + 0] *= eg.x; o[mi][4 * g4 + 1] *= eg.y; o[mi][4 * g4 + 2] *= eg.z; o[mi][4 * g4 + 3] *= eg.w;
                }
            f32x16 vn[2], tmp;
#pragma unroll
            for (int i = 0; i < 16; ++i) { vn[0][i] = 0.f; vn[1][i] = 0.f; tmp[i] = 0.f; }
#pragma unroll
            for (int s = 0; s < 2; ++s) vn[0] = MFMA32(load_perm(sT00, 40, r, 16 * s, hh), pack_step(R[0], s), vn[0]);
#pragma unroll
            for (int s = 0; s < 2; ++s) tmp = MFMA32(load_perm(sA10, 40, r, 16 * s, hh), pack_step(vn[0], s), tmp);
#pragma unroll
            for (int i = 0; i < 16; ++i) R[1][i] -= tmp[i];
#pragma unroll
            for (int s = 0; s < 2; ++s) vn[1] = MFMA32(load_perm(sT11, 40, r, 16 * s, hh), pack_step(R[1], s), vn[1]);
#pragma unroll
            for (int ci = 0; ci < 2; ++ci)
#pragma unroll
                for (int s = 0; s < 2; ++s) { const bf16x8 bf = pack_step(vn[ci], s);
#pragma unroll
                    for (int mi = 0; mi < 2; ++mi) o[mi] = MFMA32(load_perm(sP, STT, 32 * mi + r, 32 * ci + 16 * s, hh), bf, o[mi]); }
            const float eGl = sEG[63];
#pragma unroll
            for (int kt = 0; kt < 4; ++kt) for (int i = 0; i < 16; ++i) S[kt][i] *= eGl;
#pragma unroll
            for (int mi = 0; mi < 2; ++mi)
#pragma unroll
                for (int g4 = 0; g4 < 4; ++g4) { const f32x4 dl = *(const f32x4*)(sDL + 32 * mi + 8 * g4 + 4 * hh);
                    vn[mi][4 * g4 + 0] *= dl.x; vn[mi][4 * g4 + 1] *= dl.y; vn[mi][4 * g4 + 2] *= dl.z; vn[mi][4 * g4 + 3] *= dl.w; }
#pragma unroll
            for (int ci = 0; ci < 2; ++ci)
#pragma unroll
                for (int s = 0; s < 2; ++s) { const bf16x8 bf = pack_step(vn[ci], s);
#pragma unroll
                    for (int kt = 0; kt < 4; ++kt) S[kt] = MFMA32(load_perm(sKT, STT, 32 * kt + r, 32 * ci + 16 * s, hh), bf, S[kt]); }
            if (seg) {
#pragma unroll
                for (int mi = 0; mi < 2; ++mi)
#pragma unroll
                    for (int g4 = 0; g4 < 4; ++g4) { const int4 rw = *(const int4*)(sRow + 32 * mi + 8 * g4 + 4 * hh); const unsigned cb = (unsigned)(h * 128 + 32 * wave + r);
                        O[(unsigned)rw.x * 1024u + cb] = f2bf(o[mi][4 * g4 + 0]); O[(unsigned)rw.y * 1024u + cb] = f2bf(o[mi][4 * g4 + 1]);
                        O[(unsigned)rw.z * 1024u + cb] = f2bf(o[mi][4 * g4 + 2]); O[(unsigned)rw.w * 1024u + cb] = f2bf(o[mi][4 * g4 + 3]); }
            }
        }
    }
}
DI void dn_chain(const Params& p, unsigned char* smem, int dir, int b, int h) {
    if (__builtin_amdgcn_readfirstlane(threadIdx.x >> 6) < 4) dn_chain_role<true>(p, smem, dir, b, h); else dn_chain_role<false>(p, smem, dir, b, h);
}

template <bool CONS>
DI void ml_chain_role(const Params& p, unsigned char* smem, int dir, int b, int h) {
    const int tid0 = threadIdx.x, wave = __builtin_amdgcn_readfirstlane(tid0 >> 6), lane0 = tid0 & 63;
    bf16_t* sQ = (bf16_t*)(smem + LQ); bf16_t* sK = (bf16_t*)(smem + LK); bf16_t* sKT = (bf16_t*)(smem + LKT); bf16_t* sS = (bf16_t*)(smem + LPM);
    const bf16_t* P = (const bf16_t*)(p.ws + OFF_P) + (size_t)MTOT * P1W; const float* graw = (const float*)(p.ws + OFF_GRAW);
    bf16_t* O = (bf16_t*)(p.ws + OFF_A) + (size_t)dir * NLAT * 1024;
    const float igb = p.ml_ig_bias[dir * 4 + h], fgb = p.ml_fg_bias[dir * 4 + h];
    constexpr float KSC = 0.08838834764831845f;
    f32x16 C[4];
    if (CONS) {
#pragma unroll
        for (int kt = 0; kt < 4; ++kt) for (int i = 0; i < 16; ++i) C[kt][i] = 0.f;
    }
    float mstate = 0.f;
    if (tid0 < 128) ((float*)(smem + LSM) + 448)[tid0] = 0.f;
    u32x4 pq[4], pk[4]; float pig = 0.f, pfr = 0.f; int prow = 0;
    unsigned short pvv[2][2][8];
    if (!CONS) {
#pragma unroll
        for (int it = 0; it < 4; ++it) {
            const int idx = tid0 - 256 + 256 * it, i = idx >> 4, c8 = idx & 15;
            const bf16_t* src = P + (size_t)scan_row(1, dir, b, 0, 0, i) * P2W + 512 + h * 128 + c8 * 8;
            pq[it] = *(const u32x4*)src; pk[it] = *(const u32x4*)(src + 512);
        }
        if (wave == 5) { prow = scan_row(1, dir, b, 0, 0, lane0); pig = graw[(size_t)prow * 32 + 16 + dir * 4 + h]; pfr = graw[(size_t)prow * 32 + 24 + dir * 4 + h]; }
    } else {
#pragma unroll
        for (int ci = 0; ci < 2; ++ci)
#pragma unroll
            for (int s = 0; s < 2; ++s)
#pragma unroll
                for (int e = 0; e < 8; ++e) { const int row = scan_row(1, dir, b, 0, 0, 32 * ci + 16 * s + 8 * (lane0 >> 5) + e);
                    pvv[ci][s][e] = P[(size_t)row * P2W + 512 + 1024 + h * 128 + 32 * wave + (lane0 & 31)]; }
    }
    __syncthreads();

    for (int ck = 0; ck < 68; ++ck) {
        int lane = lane0; asm volatile("" : "+v"(lane));
        const int tid = (wave << 6) | lane, r = lane & 31, hh = lane >> 5;
        const int seg = ck >= 4 ? 1 : 0;
        const int nseg = (ck + 1) >= 4 ? 1 : 0, nchunk = nseg ? ck + 1 - 4 : ck + 1;
        float* sAj = (float*)(smem + LSM + ((ck & 1) ? 4096 : 0)); float* sMi = sAj + 64; float* sWin = sAj + 128; float* sFloor = sAj + 192; float* sWtok = sAj + 256; float* sRden = sAj + 320;
        int* sRow = (int*)(sAj + 384); float* sN = sAj + 448; float* sCs = sAj + 576;
        float* sNw = (float*)(smem + LSM + ((ck & 1) ? 0 : 4096)) + 448;
        bf16x8 vf[2][2];
        if (!CONS) {
#pragma unroll
            for (int it = 0; it < 4; ++it) {
                const int idx = tid - 256 + 256 * it, i = idx >> 4, c8 = idx & 15;
                *(u32x4*)(sQ + i * ST + c8 * 8) = pq[it]; *(u32x4*)(sK + i * ST + c8 * 8) = pk[it];
            }
            if (wave == 5) {
                const float ig = pig + igb, fr = pfr + fgb;
                const float lf = -softplusf_(-fr);
                float bc = lf;
#pragma unroll
                for (int o = 1; o < 64; o <<= 1) { const float t = __shfl_up(bc, o); if (lane >= o) bc += t; }
                const float blast = __shfl(bc, 63);
                const float a = ig - bc;
                float cm = a;
#pragma unroll
                for (int o = 1; o < 64; o <<= 1) { const float t = __shfl_up(cm, o); if (lane >= o) cm = fmaxf(cm, t); }
                const float amax = __shfl(cm, 63);
                const float Mall = fmaxf(mstate, amax), Mi = fmaxf(mstate, cm);
                sAj[lane] = a; sMi[lane] = Mi; sWin[lane] = expf(mstate - Mi); sFloor[lane] = expf(-(bc + Mi)); sWtok[lane] = expf(a - Mall) * KSC; sRow[lane] = prow;
                if (lane == 0) sCs[0] = expf(mstate - Mall);
                mstate = blast + Mall;
            }
            if (ck + 1 < 68) {
#pragma unroll
                for (int it = 0; it < 4; ++it) {
                    const int idx = tid - 256 + 256 * it, i = idx >> 4, c8 = idx & 15;
                    const bf16_t* src = P + (size_t)scan_row(1, dir, b, nseg, nchunk, i) * P2W + 512 + h * 128 + c8 * 8;
                    pq[it] = *(const u32x4*)src; pk[it] = *(const u32x4*)(src + 512);
                }
                if (wave == 5) { prow = scan_row(1, dir, b, nseg, nchunk, lane); pig = graw[(size_t)prow * 32 + 16 + dir * 4 + h]; pfr = graw[(size_t)prow * 32 + 24 + dir * 4 + h]; }
            }
        } else {
#pragma unroll
            for (int ci = 0; ci < 2; ++ci)
#pragma unroll
                for (int s = 0; s < 2; ++s)
#pragma unroll
                    for (int e = 0; e < 8; ++e) vf[ci][s][e] = (short)pvv[ci][s][e];
            if (ck + 1 < 68) {
                const int row0n = scan_row(1, dir, b, nseg, nchunk, 0), rstr = scan_row(1, dir, b, nseg, nchunk, 1) - row0n;
                const long long estr = (long long)rstr * P2W;
                const bf16_t* vb = P + (long long)row0n * P2W + (long long)(8 * hh) * estr + (512 + 1024 + h * 128 + 32 * wave + r);
#pragma unroll
                for (int ci = 0; ci < 2; ++ci)
#pragma unroll
                    for (int s = 0; s < 2; ++s)
#pragma unroll
                        for (int e = 0; e < 8; ++e) pvv[ci][s][e] = vb[(long long)(32 * ci + 16 * s + e) * estr];
            }
        }
        LDS_BARRIER();
        f32x16 o[2];
        if (!CONS) {
            const int w4 = wave & 3, ti = w4 >> 1, tj = w4 & 1;
            f32x16 acc; for (int i = 0; i < 16; ++i) acc[i] = 0.f;
#pragma unroll
            for (int s = 0; s < 8; ++s) { const bf16x8 a = load_nat(sQ, ST, 32 * ti + r, 16 * s + 8 * hh), bb = load_nat(sK, ST, 32 * tj + r, 16 * s + 8 * hh); acc = MFMA32(a, bb, acc); }
            const int j = 32 * tj + r; const float aj = sAj[j];
#pragma unroll
            for (int i16 = 0; i16 < 16; ++i16) { const int i = 32 * ti + crow(i16, hh); sS[i * STT + j] = f2bf(i >= j ? acc[i16] * KSC * __expf(aj - sMi[i]) : 0.f); }
            const int t = tid - 256;
            {
#pragma unroll
              for (int it = 0; it < 2; ++it) { const int item = t + 256 * it, i2 = item & 31, c8 = item >> 5;
                  const float da = sWtok[2 * i2], db = sWtok[2 * i2 + 1];
                  const bf16_t* srcp = sK + (2 * i2) * ST + c8 * 8;
                  const u32x4 ka = *(const u32x4*)srcp, kb = *(const u32x4*)(srcp + ST);
                  unsigned* d = (unsigned*)(sKT + (8 * c8) * STT) + i2;
                  d[0 * (STT / 2)] = pk2(bflo(ka.x) * da, bflo(kb.x) * db); d[1 * (STT / 2)] = pk2(bfhi(ka.x) * da, bfhi(kb.x) * db);
                  d[2 * (STT / 2)] = pk2(bflo(ka.y) * da, bflo(kb.y) * db); d[3 * (STT / 2)] = pk2(bfhi(ka.y) * da, bfhi(kb.y) * db);
                  d[4 * (STT / 2)] = pk2(bflo(ka.z) * da, bflo(kb.z) * db); d[5 * (STT / 2)] = pk2(bfhi(ka.z) * da, bfhi(kb.z) * db);
                  d[6 * (STT / 2)] = pk2(bflo(ka.w) * da, bflo(kb.w) * db); d[7 * (STT / 2)] = pk2(bfhi(ka.w) * da, bfhi(kb.w) * db); } }
        } else {
#pragma unroll
            for (int mi = 0; mi < 2; ++mi) for (int i = 0; i < 16; ++i) o[mi][i] = 0.f;
#pragma unroll
            for (int kt = 0; kt < 4; ++kt)
#pragma unroll
                for (int s = 0; s < 2; ++s) { const bf16x8 bf = pack_step(C[kt], s);
#pragma unroll
                    for (int mi = 0; mi < 2; ++mi) o[mi] = MFMA32(load_perm(sQ, ST, 32 * mi + r, 32 * kt + 16 * s, hh), bf, o[mi]); }
#pragma unroll
            for (int mi = 0; mi < 2; ++mi)
#pragma unroll
                for (int i = 0; i < 16; ++i) o[mi][i] *= sWin[32 * mi + crow(i, hh)];
        }
        LDS_BARRIER();
        if (!CONS) {
            const int t = tid - 256;
            { const int i = t >> 2, part = t & 3; float qn = 0.f, rs = 0.f;
#pragma unroll
              for (int q = 0; q < 4; ++q) { const u32x4 qv = *(const u32x4*)(sQ + i * ST + part * 32 + 8 * q);
                  const f32x4 n0 = *(const f32x4*)(sN + part * 32 + 8 * q), n1 = *(const f32x4*)(sN + part * 32 + 8 * q + 4);
                  qn += (bflo(qv.x) * n0.x + bfhi(qv.x) * n0.y) + (bflo(qv.y) * n0.z + bfhi(qv.y) * n0.w) + (bflo(qv.z) * n1.x + bfhi(qv.z) * n1.y) + (bflo(qv.w) * n1.z + bfhi(qv.w) * n1.w); }
#pragma unroll
              for (int q = 0; q < 2; ++q) { const u32x4 sv = *(const u32x4*)(sS + i * STT + part * 16 + 8 * q);
                  rs += (bflo(sv.x) + bfhi(sv.x)) + (bflo(sv.y) + bfhi(sv.y)) + (bflo(sv.z) + bfhi(sv.z)) + (bflo(sv.w) + bfhi(sv.w)); }
              qn += __shfl_xor(qn, 1); qn += __shfl_xor(qn, 2); rs += __shfl_xor(rs, 1); rs += __shfl_xor(rs, 2);
              if (part == 0) { const float den = sWin[i] * qn + rs; sRden[i] = 1.f / fmaxf(fabsf(den), sFloor[i]); } }
            if (wave < 6) {
                const int k = t; float acc = sCs[0] * sN[k];
#pragma unroll
                for (int q = 0; q < 8; ++q) { const u32x4 kv = *(const u32x4*)(sKT + k * STT + 8 * q);
                    acc += (bflo(kv.x) + bfhi(kv.x)) + (bflo(kv.y) + bfhi(kv.y)) + (bflo(kv.z) + bfhi(kv.z)) + (bflo(kv.w) + bfhi(kv.w)); }
                sNw[k] = acc;
            }
        } else {
#pragma unroll
            for (int ci = 0; ci < 2; ++ci)
#pragma unroll
                for (int s = 0; s < 2; ++s)
#pragma unroll
                    for (int mi = 0; mi < 2; ++mi) o[mi] = MFMA32(load_nat(sS, STT, 32 * mi + r, 32 * ci + 16 * s + 8 * hh), vf[ci][s], o[mi]);
        }
        LDS_BARRIER();
        const float cs = sCs[0];
        if (CONS) {
            if (seg) {
#pragma unroll
                for (int mi = 0; mi < 2; ++mi)
#pragma unroll
                    for (int i = 0; i < 16; ++i) { const int il = 32 * mi + crow(i, hh); const unsigned off = (unsigned)sRow[il] * 1024u + (unsigned)(512 + h * 128 + 32 * wave + r);
                        O[off] = f2bf(o[mi][i] * sRden[il]); }
            }
#pragma unroll
            for (int kt = 0; kt < 4; ++kt) for (int i = 0; i < 16; ++i) C[kt][i] *= cs;
#pragma unroll
            for (int ci = 0; ci < 2; ++ci)
#pragma unroll
                for (int s = 0; s < 2; ++s)
#pragma unroll
                    for (int kt = 0; kt < 4; ++kt) C[kt] = MFMA32(load_nat(sKT, STT, 32 * kt + r, 32 * ci + 16 * s + 8 * hh), vf[ci][s], C[kt]);
        }
    }
}

DI void ml_chain(const Params& p, unsigned char* smem, int dir, int b, int h) {
    if (__builtin_amdgcn_readfirstlane(threadIdx.x >> 6) < 4) ml_chain_role<true>(p, smem, dir, b, h); else ml_chain_role<false>(p, smem, dir, b, h);
}

DI void scan_phase(const Params& p, unsigned char* smem) {
    const int ch = blockIdx.x;
    if (ch < 256) {
        const int type = ch & 1, dir = (ch >> 1) & 1, h = (ch >> 2) & 3, b = ch >> 4;
#ifdef ONLY_DN
        dn_chain(p, smem, dir, b, h);
#elif defined(ONLY_ML)
        ml_chain(p, smem, dir, b, h);
#else
        if (type == 0) dn_chain(p, smem, dir, b, h); else ml_chain(p, smem, dir, b, h);
#endif
        __syncthreads();
    }
}

DI void finalize_phase(const Params& p) {
    const int wave = threadIdx.x >> 6, lane = threadIdx.x & 63;
    const int gw = blockIdx.x * 8 + wave, NGW = gridDim.x * 8;
    bf16_t* O0 = (bf16_t*)(p.ws + OFF_A); const bf16_t* O1 = O0 + (size_t)NLAT * 1024; const bf16_t* P = (const bf16_t*)(p.ws + OFF_P) + (size_t)MTOT * P1W;
    for (int row = gw; row < NLAT; row += NGW) {
#pragma unroll
        for (int part = 0; part < 2; ++part) {
            const int col = 512 * part + 8 * lane;
            const u32x4 a = *(const u32x4*)(O0 + (size_t)row * 1024 + col), bq = *(const u32x4*)(O1 + (size_t)row * 1024 + col);
            const u32x4 gt = *(const u32x4*)(P + (size_t)row * P2W + (part ? 2048 : 0) + 8 * lane);
            float o[8], g[8];
            o[0] = bflo(a.x) + bflo(bq.x); o[1] = bfhi(a.x) + bfhi(bq.x); o[2] = bflo(a.y) + bflo(bq.y); o[3] = bfhi(a.y) + bfhi(bq.y);
            o[4] = bflo(a.z) + bflo(bq.z); o[5] = bfhi(a.z) + bfhi(bq.z); o[6] = bflo(a.w) + bflo(bq.w); o[7] = bfhi(a.w) + bfhi(bq.w);
            g[0] = bflo(gt.x); g[1] = bfhi(gt.x); g[2] = bflo(gt.y); g[3] = bfhi(gt.y); g[4] = bflo(gt.z); g[5] = bfhi(gt.z); g[6] = bflo(gt.w); g[7] = bfhi(gt.w);
            float ss = 0.f;
#pragma unroll
            for (int e = 0; e < 8; ++e) ss += o[e] * o[e];
            ss += __shfl_xor(ss, 1); ss += __shfl_xor(ss, 2); ss += __shfl_xor(ss, 4); ss += __shfl_xor(ss, 8);
            const float rstd = rsqrtf(ss * (1.f / 128.f) + EPS);
            const float* nw = part ? p.ml_norm + 8 * lane : p.dn_norm + ((8 * lane) & 127);
            const f32x4 n0 = *(const f32x4*)nw, n1 = *(const f32x4*)(nw + 4);
            const float nn[8] = {n0.x, n0.y, n0.z, n0.w, n1.x, n1.y, n1.z, n1.w};
            float y[8];
#pragma unroll
            for (int e = 0; e < 8; ++e) y[e] = o[e] * rstd * nn[e] * (part ? sigmoidf_(g[e]) : siluf_(g[e]));
            u32x4 ov; ov.x = pk2(y[0], y[1]); ov.y = pk2(y[2], y[3]); ov.z = pk2(y[4], y[5]); ov.w = pk2(y[6], y[7]);
            *(u32x4*)(O0 + (size_t)row * 1024 + col) = ov;
        }
    }
}

constexpr int NPHASE = 11;
constexpr int LDS_BYTES = SCAN_LDS > pg8::STAGE_BYTES ? SCAN_LDS : pg8::STAGE_BYTES;

#ifndef REPEAT_MASK
#define REPEAT_MASK 0
#endif
template <int PH>
DI void run_phase(const Params& p, unsigned char* smem) {
    LAS unsigned char* lds = (LAS unsigned char*)smem;
    if constexpr (PH == 0) phase0(p, smem);
    if constexpr (PH == 1) norm_rows<0>(p);
    if constexpr (PH == 2) { pg8::Gemm g{(const bf16_t*)(p.ws + OFF_A), (const bf16_t*)(p.ws + OFF_WIN), MTOT, 4096, 1024};
                  pg8::StaticOrder S; S.init(g.M, g.N, gridDim.x, blockIdx.x);
                  pg8::EpiBf16 E{(bf16_t*)(p.ws + OFF_P), (bf16_t*)(p.ws + OFF_P) + (size_t)MTOT * P1W};
                  pg8::gemm_phase(lds, g, S, E);
                  gates_gemm(p); }
    if constexpr (PH == 3) dn_conv_phase(p);
    if constexpr (PH == 4) scan_phase(p, smem);
    if constexpr (PH == 5) finalize_phase(p);
    if constexpr (PH == 6) { pg8::Gemm g{(const bf16_t*)(p.ws + OFF_A), (const bf16_t*)(p.ws + OFF_WOUT), NLAT, 1024, 1024};
                  pg8::StaticOrder S; S.init(g.M, g.N, gridDim.x, blockIdx.x);
                  pg8::EpiResB E{p.x, (bf16_t*)(p.ws + OFF_X1B), (const float*)(p.ws + OFF_MOD) + 2048};
                  pg8::gemm_phase(lds, g, S, E); }
    if constexpr (PH == 7) norm_rows_b(p);
    if constexpr (PH == 8) { pg8::Gemm g{(const bf16_t*)(p.ws + OFF_A) + (size_t)NLAT * 1024, (const bf16_t*)(p.ws + OFF_WFF1), NLAT, 5632, 1024};
                  pg8::StaticOrder S; S.init(g.M, g.N, gridDim.x, blockIdx.x);
                  pg8::EpiSwiglu E{(bf16_t*)(p.ws + OFF_P)};
                  pg8::gemm_phase(lds, g, S, E); }
    if constexpr (PH == 9) { pg8::Gemm g{(const bf16_t*)(p.ws + OFF_P), (const bf16_t*)(p.ws + OFF_WFF2), NLAT, 1024, DFF};
                  pg8::StaticOrder S; S.init(g.M, g.N, gridDim.x, blockIdx.x);
                  pg8::EpiResFromB E{(bf16_t*)(p.ws + OFF_X1B), (const float*)(p.ws + OFF_MOD) + 5120};
                  pg8::gemm_phase(lds, g, S, E); }
    if constexpr (PH == 10) final_norm_b(p);
}

#define XB_TMO      128
#define XB_XCNT(j)  (256  + 64 * (j))
#define XB_XSUB(j)  (1280 + 64 * (j))
#define XB_XGEN(j)  (2304 + 64 * (j))
#define XB_TOP      3328
#define XB_TOPGEN   3392
#define XCD_BAR_WORDS 3456
#define XB_SPIN_CAP (1u << 22)
DI unsigned xb_ld(unsigned* p)              { return __hip_atomic_load(p, __ATOMIC_RELAXED, __HIP_MEMORY_SCOPE_AGENT); }
DI unsigned xb_add(unsigned* p, unsigned v) { return __hip_atomic_fetch_add(p, v, __ATOMIC_RELAXED, __HIP_MEMORY_SCOPE_AGENT); }
DI unsigned xb_xcc_id() { return (unsigned)__builtin_amdgcn_s_getreg((3 << 11) | 20) & 0xFu; }
#define XB_SPIN(cond, bar) do { unsigned _sp = 0; while (cond) { __builtin_amdgcn_s_sleep(1); \
    if ((++_sp & 255u) == 0u) { if (xb_ld(&(bar)[XB_TMO])) break; if (_sp > XB_SPIN_CAP) { atomicAdd(&(bar)[XB_TMO], 1u); break; } } } } while (0)
struct XcdBarrier { unsigned* bar; unsigned x; volatile LAS unsigned* st; };
DI XcdBarrier xcd_barrier_post(unsigned* bar, volatile LAS unsigned* st) {
    XcdBarrier b; b.bar = bar; b.x = xb_xcc_id(); b.st = st;
    if (threadIdx.x == 0) (void)xb_add(&bar[XB_XCNT(b.x)], 1u);
    return b;
}
DI void xcd_barrier_complete(unsigned* bar, unsigned x, unsigned& nloc, unsigned& nx) {
    const unsigned G = gridDim.x * gridDim.y * gridDim.z;
    unsigned sum, cnt, mine, sp = 0u;
    for (;;) {
        sum = 0u; cnt = 0u; mine = 0u;
#pragma unroll
        for (unsigned j = 0; j < 16; ++j) { const unsigned c = xb_ld(&bar[XB_XCNT(j)]); sum += c; cnt += (c > 0u) ? 1u : 0u; mine = (j == x) ? c : mine; }
        if (sum == G) break;
        __builtin_amdgcn_s_sleep(1);
        if ((++sp & 255u) == 0u) { if (xb_ld(&bar[XB_TMO])) break; if (sp > XB_SPIN_CAP) { atomicAdd(&bar[XB_TMO], 1u); break; } }
    }
    nloc = mine > 0u ? mine : 1u; nx = cnt > 0u ? cnt : 1u;
}
DI void xcd_barrier(const XcdBarrier& b) {
    asm volatile("s_waitcnt vmcnt(0)" ::: "memory");
    __syncthreads();
    if (threadIdx.x == 0) {
        unsigned* bar = b.bar;
        __builtin_amdgcn_s_waitcnt(0);
        unsigned nloc = b.st[0], nx = b.st[1];
        if (nloc == 0u) { xcd_barrier_complete(bar, b.x, nloc, nx); b.st[0] = nloc; b.st[1] = nx; }
        const unsigned old = xb_add(&bar[XB_XSUB(b.x)], 1u);
        const unsigned gen = old / nloc;
        if (old + 1u == (gen + 1u) * nloc) {
            __builtin_amdgcn_fence(__ATOMIC_RELEASE, "agent");
            asm volatile("s_waitcnt vmcnt(0)" ::: "memory");
            const unsigned og = xb_add(&bar[XB_TOP], 1u);
            const unsigned tg = og / nx;
            if (og + 1u == (tg + 1u) * nx) xb_add(&bar[XB_TOPGEN], 1u);
            else XB_SPIN(xb_ld(&bar[XB_TOPGEN]) == tg, bar);
            __builtin_amdgcn_fence(__ATOMIC_ACQUIRE, "agent");
            xb_add(&bar[XB_XGEN(b.x)], 1u);
            asm volatile("s_waitcnt vmcnt(0)" ::: "memory");
        } else {
            XB_SPIN(xb_ld(&bar[XB_XGEN(b.x)]) == gen, bar);
            __builtin_amdgcn_fence(__ATOMIC_ACQUIRE, "agent");
            asm volatile("s_waitcnt vmcnt(0)" ::: "memory");
        }
    }
    __syncthreads();
}

__global__ void __launch_bounds__(512, 2) mega(Params p) {
    extern __shared__ __attribute__((aligned(16))) unsigned char smem[];
    unsigned* bar = (unsigned*)(p.ws + OFF_BAR);
    volatile LAS unsigned* st = (volatile LAS unsigned*)((LAS unsigned char*)smem + LDS_BYTES);
    if (threadIdx.x < 2) st[threadIdx.x] = 0u;
    __syncthreads();
    const XcdBarrier xb = xcd_barrier_post(bar, st);
#define SEAM(n) do { if ((n) == 0) cg::this_grid().sync(); else xcd_barrier(xb); } while (0)
#define PH(n) if (p.ph_lo <= (n) && (n) < p.ph_hi) { run_phase<n>(p, smem); \
        if ((REPEAT_MASK >> (n)) & 1) { SEAM(n); run_phase<n>(p, smem); } \
        if ((n) + 1 < p.ph_hi) SEAM(n); }
    PH(0) PH(1) PH(2) PH(3) PH(4) PH(5) PH(6) PH(7) PH(8) PH(9) PH(10)
#undef PH
#undef SEAM
}

extern "C" void kernel_launch(void* const* d_in, const int* in_sizes, int n_in, void* d_out, int out_size, void* d_ws, size_t ws_size, hipStream_t stream) {
    static int grid = 0;
    if (grid == 0) {
        if (n_in != 20 || out_size != NLAT * DM || ws_size < WS_END) { fprintf(stderr, "kernel_launch: unexpected shapes (n_in %d out %d ws %zu need %zu)\n", n_in, out_size, ws_size, (size_t)WS_END); grid = -1; return; }
        if (hipFuncSetAttribute((const void*)mega, hipFuncAttributeMaxDynamicSharedMemorySize, LDS_BYTES + 16) != hipSuccess) { fprintf(stderr, "hipFuncSetAttribute failed\n"); grid = -1; return; }
        int dev = 0, cus = 0, per_cu = 0;
        hipGetDevice(&dev); hipDeviceGetAttribute(&cus, hipDeviceAttributeMultiprocessorCount, dev);
        hipOccupancyMaxActiveBlocksPerMultiprocessor(&per_cu, (const void*)mega, 512, LDS_BYTES + 16);
        if (per_cu < 1) { fprintf(stderr, "occupancy query says %d blocks per CU\n", per_cu); per_cu = 1; }
        (void)hipGetLastError();
        grid = cus;
    }
    if (grid < 0) return;
    Params p{};
    const float** f = (const float**)&p;
    for (int i = 0; i < 20; ++i) f[i] = (const float*)d_in[i];
    p.out = (float*)d_out; p.ws = (unsigned char*)d_ws;
#if N_LAUNCH_PER_PHASE
    for (int ph = 0; ph < NPHASE; ++ph) {
        p.ph_lo = ph; p.ph_hi = ph + 1;
        hipLaunchKernelGGL(mega, dim3(grid), dim3(512), LDS_BYTES + 16, stream, p);
    }
#else
    p.ph_lo = 0; p.ph_hi = NPHASE;
    if (hipMemsetAsync((unsigned char*)d_ws + OFF_BAR, 0, XCD_BAR_WORDS * 4, stream) != hipSuccess) { fprintf(stderr, "memset of the barrier counter failed\n"); return; }
    void* args[] = {&p};
    hipError_t e = hipLaunchCooperativeKernel((const void*)mega, dim3(grid), dim3(512), args, LDS_BYTES + 16, stream);
    if (e != hipSuccess) fprintf(stderr, "cooperative launch failed: %s (grid %d)\n", hipGetErrorString(e), grid);
#endif
}
```

```cpp
#include <hip/hip_runtime.h>
#include <hip/hip_cooperative_groups.h>
#include <cstdio>
namespace cg = cooperative_groups;

#ifndef N_LAUNCH_PER_PHASE
#define N_LAUNCH_PER_PHASE 0
#endif

#define LAS __attribute__((address_space(3)))
typedef unsigned short bf16_t;
typedef short bf16x8 __attribute__((ext_vector_type(8)));
typedef float f32x4 __attribute__((ext_vector_type(4)));
typedef float f32x2 __attribute__((ext_vector_type(2)));
typedef float f32x16 __attribute__((ext_vector_type(16)));
typedef unsigned u32x4 __attribute__((ext_vector_type(4)));
typedef unsigned u32x2 __attribute__((ext_vector_type(2)));
typedef __bf16 bf16x2_t __attribute__((ext_vector_type(2)));
#define DI __device__ __forceinline__

constexpr int NB = 16, SEQ = 4096, CTXL = 256, DM = 1024, DFF = 2816;
constexpr int NLAT = NB * SEQ;
constexpr int NCTX = NB * CTXL;
constexpr int MTOT = NLAT + NCTX;
constexpr int PW = 4096;
constexpr int P1W = 1536, P2W = 2560;
constexpr int NMODC = 6144;
constexpr float EPS = 1e-6f;

constexpr size_t OFF_WIN  = 0;
constexpr size_t OFF_WG   = OFF_WIN  + (size_t)4096 * 1024 * 2;
constexpr size_t OFF_WOUT = OFF_WG   + (size_t)32 * 1024 * 2;
constexpr size_t OFF_WFF1 = OFF_WOUT + (size_t)1024 * 1024 * 2;
constexpr size_t OFF_WFF2 = OFF_WFF1 + (size_t)5632 * 1024 * 2;
constexpr size_t OFF_MOD  = OFF_WFF2 + (size_t)1024 * 2816 * 2;
constexpr size_t OFF_GRAW = OFF_MOD  + (size_t)17 * 6144 * 4;
constexpr size_t OFF_A    = ((OFF_GRAW + (size_t)MTOT * 32 * 4) + 4095) / 4096 * 4096;
constexpr size_t OFF_P    = OFF_A + (size_t)2 * NLAT * 1024 * 2;
constexpr size_t OFF_BAR  = OFF_P + (size_t)MTOT * PW * 2;
constexpr size_t OFF_X1B  = OFF_BAR + 16384;
constexpr size_t WS_END   = OFF_X1B + (size_t)NLAT * 1024 * 2;

struct Params {
    const float *x, *c, *ctx, *c_ctx, *w_mod, *b_mod, *norm1, *w_in, *dn_conv, *dn_a_log, *dn_dt_bias, *dn_norm,
                *ml_ig_bias, *ml_fg_bias, *ml_norm, *w_out, *norm2, *w_ffn_in, *w_ffn_out, *final_norm;
    float* out; unsigned char* ws;
    int ph_lo, ph_hi;
};

DI unsigned pk2(float a, float b) { f32x2 v = {a, b}; bf16x2_t r = __builtin_convertvector(v, bf16x2_t); return __builtin_bit_cast(unsigned, r); }
DI bf16_t f2bf(float a) { return (bf16_t)(pk2(a, 0.f) & 0xffffu); }
DI float bf2f(bf16_t v) { return __uint_as_float(((unsigned)v) << 16); }
DI float bflo(unsigned u) { return __uint_as_float(u << 16); }
DI float bfhi(unsigned u) { return __uint_as_float(u & 0xffff0000u); }
DI float sigmoidf_(float x) { return __builtin_amdgcn_rcpf(1.f + __expf(-x)); }
DI float siluf_(float x) { return x * __builtin_amdgcn_rcpf(1.f + __expf(-x)); }
DI float softplusf_(float x) { return x > 20.f ? x : log1pf(expf(x)); }
DI float wave_sum(float v) {
#pragma unroll
    for (int o = 1; o < 64; o <<= 1) v += __shfl_xor(v, o);
    return v;
}
#define MFMA32(a, b, c) __builtin_amdgcn_mfma_f32_32x32x16_bf16((a), (b), (c), 0, 0, 0)
DI float fnma_(float a, float x, float acc) { asm("v_fma_f32 %0, -%1, %2, %0" : "+v"(acc) : "v"(a), "v"(x)); return acc; }
DI int crow(int reg, int hh) { return (reg & 3) + 8 * (reg >> 2) + 4 * hh; }
DI bf16x8 pack_step(const f32x16& x, int s) {
    u32x4 p;
    p.x = pk2(x[8 * s + 0], x[8 * s + 1]); p.y = pk2(x[8 * s + 2], x[8 * s + 3]);
    p.z = pk2(x[8 * s + 4], x[8 * s + 5]); p.w = pk2(x[8 * s + 6], x[8 * s + 7]);
    return __builtin_bit_cast(bf16x8, p);
}
DI bf16x8 load_perm(const bf16_t* base, int stride, int row, int kbase, int hh) {
    const bf16_t* p = base + row * stride + kbase + 4 * hh;
    u32x2 lo = *(const u32x2*)p, hi = *(const u32x2*)(p + 8);
    u32x4 v; v.x = lo.x; v.y = lo.y; v.z = hi.x; v.w = hi.y;
    return __builtin_bit_cast(bf16x8, v);
}
DI bf16x8 load_nat(const bf16_t* base, int stride, int row, int k0) { return *(const bf16x8*)(base + row * stride + k0); }

namespace pg8 {
constexpr int BM = 256, BK = 64, HALF = 128, HTB = HALF * BK * 2, STAGE_BYTES = 8 * HTB, NXCD = 8, WGM = 8;
DI int lds_byte(int r, int c) { const int st = (r >> 4) * 2 + (c >> 5), rr = r & 15, cc = c & 31, ob = rr * 64 + cc * 2; return st * 1024 + (ob ^ (((ob >> 9) & 1) << 5)); }
DI void stage_rc(int b, int& R, int& C) { const int st = b / 1024, sb = b % 1024, swz = sb ^ (((sb >> 9) & 1) << 5); R = (st >> 1) * 16 + swz / 64; C = (st & 1) * 32 + (swz % 64) / 2; }
DI int perm32(int rho) { const int n = rho >> 4, i = rho & 15; return 8 * (i >> 2) + 4 * n + (i & 3); }
struct Unit { int pm, pn; };
struct Gemm { const bf16_t* A; const bf16_t* Bt; int M, N, K; };
struct StaticOrder {
    int nM, nN, nwg, G, c;
    DI void init(int M, int N, int G_, int c_) { nM = M / BM; nN = N / BM; nwg = nM * nN; G = G_; c = c_; }
    DI bool next(int i, Unit& u) const {
        const long L = (long)i * G + c; if (L >= nwg) return false;
        int wgid = (int)L; { const int q = nwg / NXCD, r = nwg % NXCD, xcd = wgid % NXCD, off = wgid / NXCD; wgid = (xcd < r ? xcd * (q + 1) : r * (q + 1) + (xcd - r) * q) + off; }
        const int nig = WGM * nN, gid = wgid / nig, fm = gid * WGM, gsz = (nM - fm) < WGM ? (nM - fm) : WGM;
        u.pm = fm + ((wgid % nig) % gsz); u.pn = (wgid % nig) / gsz; return true;
    }
};

template <class Epi>
DI void gemm_phase(LAS unsigned char* lds, const Gemm g, const StaticOrder& S, const Epi& E) {
    const int tid = threadIdx.x, wid = __builtin_amdgcn_readfirstlane(tid >> 6), lane = tid & 63, wr = wid >> 2, wc = wid & 3, fr = lane & 15, fq = lane >> 4;
    const int K = g.K, nt = K / BK;
    unsigned voffA[2], voffB[2];
#pragma unroll
    for (int i = 0; i < 2; ++i) { int R, C; stage_rc(tid * 16 + i * 8192, R, C); const int Rb = Epi::PERM ? ((R & ~31) + perm32(R & 31)) : R;
        voffA[i] = (unsigned)(R * K + C) * 2u; voffB[i] = (unsigned)(Rb * K + C) * 2u; }
    const size_t kstep = (size_t)(BK * 2);
    const size_t hstep = (size_t)HALF * K * 2;
    const size_t tstep = 2 * hstep;
    const unsigned ldsw = (unsigned)wid * 1024u;
    const int aoff = lds_byte(wr * 64 + fr, fq * 8), boff = lds_byte(wc * 32 + fr, fq * 8);
#define PG8_SA(b, h) (((b) * 2 + (h)) * HTB)
#define PG8_SB(b, h) ((4 + (b) * 2 + (h)) * HTB)
#define PG8_STAGE(bufoff, gbase, voff) do { _Pragma("unroll") for (int _i = 0; _i < 2; ++_i) \
        __builtin_amdgcn_global_load_lds((const unsigned*)((const char*)(gbase) + (voff)[_i]), (LAS unsigned*)(lds + (bufoff) + ldsw + _i * 8192), 16, 0, 0); } while (0)
#define PG8_LDA(dst, b, h) do { _Pragma("unroll") for (int m = 0; m < 4; ++m) _Pragma("unroll") for (int k = 0; k < 2; ++k) dst[m][k] = *(const LAS bf16x8*)(lds + PG8_SA(b, h) + aoff + m * 2048 + k * 1024); } while (0)
#define PG8_LDB(dst, b, h) do { _Pragma("unroll") for (int n = 0; n < 2; ++n) _Pragma("unroll") for (int k = 0; k < 2; ++k) dst[n][k] = *(const LAS bf16x8*)(lds + PG8_SB(b, h) + boff + n * 2048 + k * 1024); } while (0)
#define PG8_MMA(ai, bj, At, Bt) do { __builtin_amdgcn_s_setprio(1); _Pragma("unroll") for (int m = 0; m < 4; ++m) _Pragma("unroll") for (int n = 0; n < 2; ++n) _Pragma("unroll") for (int k = 0; k < 2; ++k) \
        acc[ai][bj][m][n] = __builtin_amdgcn_mfma_f32_16x16x32_bf16(Bt[n][k], At[m][k], acc[ai][bj][m][n], 0, 0, 0); __builtin_amdgcn_s_setprio(0); } while (0)
#define PG8_WAIT_V(n) asm volatile("s_waitcnt vmcnt(" #n ")" ::: "memory")
#define PG8_WAIT_L(n) asm volatile("s_waitcnt lgkmcnt(" #n ")" ::: "memory")
#define PG8_BAR __builtin_amdgcn_s_barrier()
#define PG8_SCHED __builtin_amdgcn_sched_barrier(0)
    Unit cur, nxt; int ui = 0;
    if (!S.next(0, cur)) return;
    f32x4 acc[2][2][4][2];
#pragma unroll
    for (int a = 0; a < 2; ++a)
#pragma unroll
        for (int b = 0; b < 2; ++b)
#pragma unroll
            for (int m = 0; m < 4; ++m)
#pragma unroll
                for (int n = 0; n < 2; ++n) acc[a][b][m][n] = (f32x4){0.f, 0.f, 0.f, 0.f};
    bf16x8 At[4][2], B0[2][2], B1[2][2];
    const char* cA = (const char*)g.A + (size_t)cur.pm * tstep; const char* cB = (const char*)g.Bt + (size_t)cur.pn * tstep;
    PG8_STAGE(PG8_SB(0, 0), cB, voffB); PG8_STAGE(PG8_SA(0, 0), cA, voffA); PG8_STAGE(PG8_SB(0, 1), cB + hstep, voffB); PG8_STAGE(PG8_SA(0, 1), cA + hstep, voffA);
    if (wr == 1) PG8_BAR;
    PG8_WAIT_V(4); PG8_BAR;
    PG8_STAGE(PG8_SB(1, 0), cB + kstep, voffB); PG8_STAGE(PG8_SA(1, 0), cA + kstep, voffA); PG8_STAGE(PG8_SB(1, 1), cB + hstep + kstep, voffB);
    PG8_WAIT_V(6); PG8_BAR;
    for (;;) {
        const bool has_next = S.next(ui + 1, nxt);
        const char* nA = has_next ? (const char*)g.A + (size_t)nxt.pm * tstep : cA; const char* nB = has_next ? (const char*)g.Bt + (size_t)nxt.pn * tstep : cB;
        for (int t = 0; t < nt; t += 2) {
            const bool last = (t == nt - 2);
            const char* a1 = cA + (size_t)(t + 1) * kstep;
            const char* a2 = last ? nA : cA + (size_t)(t + 2) * kstep; const char* b2 = last ? nB : cB + (size_t)(t + 2) * kstep;
            const char* a3 = a2 + kstep; const char* b3 = b2 + kstep;
            PG8_LDB(B0, 0, 0); PG8_SCHED; PG8_LDA(At, 0, 0); PG8_STAGE(PG8_SA(1, 1), a1 + hstep, voffA);
            PG8_WAIT_L(8); PG8_BAR; PG8_WAIT_L(0); PG8_MMA(0, 0, At, B0); PG8_BAR; PG8_SCHED;
            PG8_LDB(B1, 0, 1); PG8_STAGE(PG8_SB(0, 0), b2, voffB);
            PG8_BAR; PG8_WAIT_L(0); PG8_MMA(0, 1, At, B1); PG8_BAR;
            PG8_LDA(At, 0, 1); PG8_STAGE(PG8_SA(0, 0), a2, voffA);
            PG8_BAR; PG8_WAIT_L(0); PG8_MMA(1, 0, At, B0); PG8_BAR; PG8_SCHED;
            PG8_STAGE(PG8_SB(0, 1), b2 + hstep, voffB);
            PG8_WAIT_V(6); PG8_BAR; PG8_MMA(1, 1, At, B1); PG8_BAR;
            PG8_LDB(B0, 1, 0); PG8_SCHED; PG8_LDA(At, 1, 0); PG8_STAGE(PG8_SA(0, 1), a2 + hstep, voffA);
            PG8_WAIT_L(8); PG8_BAR; PG8_WAIT_L(0); PG8_MMA(0, 0, At, B0); PG8_BAR; PG8_SCHED;
            PG8_LDB(B1, 1, 1); PG8_STAGE(PG8_SB(1, 0), b3, voffB);
            PG8_BAR; PG8_WAIT_L(0); PG8_MMA(0, 1, At, B1); PG8_BAR;
            PG8_LDA(At, 1, 1); PG8_STAGE(PG8_SA(1, 0), a3, voffA);
            PG8_BAR; PG8_WAIT_L(0); PG8_MMA(1, 0, At, B0); PG8_BAR; PG8_SCHED;
            PG8_STAGE(PG8_SB(1, 1), b3 + hstep, voffB);
            PG8_WAIT_V(6); PG8_BAR; PG8_MMA(1, 1, At, B1); PG8_BAR;
        }
        E(acc, cur, wr, wc, fr, fq);
        if (!has_next) break;
#pragma unroll
        for (int a = 0; a < 2; ++a)
#pragma unroll
            for (int b = 0; b < 2; ++b)
#pragma unroll
                for (int m = 0; m < 4; ++m)
#pragma unroll
                    for (int n = 0; n < 2; ++n) acc[a][b][m][n] = (f32x4){0.f, 0.f, 0.f, 0.f};
        cur = nxt; cA = nA; cB = nB; ++ui;
    }
    PG8_WAIT_V(0);
    if (wr == 0) PG8_BAR;
    PG8_BAR;
#undef PG8_SA
#undef PG8_SB
#undef PG8_STAGE
#undef PG8_LDA
#undef PG8_LDB
#undef PG8_MMA
#undef PG8_WAIT_V
#undef PG8_WAIT_L
#undef PG8_BAR
#undef PG8_SCHED
}

struct EpiBf16 {
    static constexpr bool PERM = true;
    bf16_t* O1; bf16_t* O2;
    DI void operator()(const f32x4 (&acc)[2][2][4][2], const Unit& u, int wr, int wc, int fr, int fq) const {
        const bool first = u.pn < 6; const int ldc = first ? P1W : P2W;
        const int row0 = u.pm * BM + wr * 64 + fr, col0 = (first ? u.pn : u.pn - 6) * BM + wc * 32 + 8 * fq;
        bf16_t* O = first ? O1 : O2;
#pragma unroll
        for (int ai = 0; ai < 2; ++ai)
#pragma unroll
            for (int m = 0; m < 4; ++m) { bf16_t* rowp = O + (size_t)(row0 + ai * HALF + m * 16) * ldc + col0;
#pragma unroll
                for (int bj = 0; bj < 2; ++bj) { const f32x4 v0 = acc[ai][bj][m][0], v1 = acc[ai][bj][m][1];
                    u32x4 w; w.x = pk2(v0[0], v0[1]); w.y = pk2(v0[2], v0[3]); w.z = pk2(v1[0], v1[1]); w.w = pk2(v1[2], v1[3]);
                    *(u32x4*)(rowp + bj * HALF) = w; } }
    }
};
struct EpiSwiglu {
    static constexpr bool PERM = true;
    bf16_t* O;
    DI void operator()(const f32x4 (&acc)[2][2][4][2], const Unit& u, int wr, int wc, int fr, int fq) const {
        const int row0 = u.pm * BM + wr * 64 + fr, col0 = u.pn * HALF + wc * 32 + 8 * fq;
#pragma unroll
        for (int ai = 0; ai < 2; ++ai)
#pragma unroll
            for (int m = 0; m < 4; ++m) { bf16_t* rowp = O + (size_t)(row0 + ai * HALF + m * 16) * DFF + col0;
                f32x4 v0, v1;
#pragma unroll
                for (int j = 0; j < 4; ++j) { v0[j] = siluf_(acc[ai][0][m][0][j]) * acc[ai][1][m][0][j]; v1[j] = siluf_(acc[ai][0][m][1][j]) * acc[ai][1][m][1][j]; }
                u32x4 w; w.x = pk2(v0[0], v0[1]); w.y = pk2(v0[2], v0[3]); w.z = pk2(v1[0], v1[1]); w.w = pk2(v1[2], v1[3]);
                *(u32x4*)rowp = w; }
    }
};
struct EpiRes {
    static constexpr bool PERM = true;
    const float* base; float* out; const float* gate;
    DI void operator()(const f32x4 (&acc)[2][2][4][2], const Unit& u, int wr, int wc, int fr, int fq) const {
        const int row0 = u.pm * BM + wr * 64 + fr, col0 = u.pn * BM + wc * 32 + 8 * fq;
        const float* gp = gate + (size_t)((u.pm * BM) >> 12) * NMODC + col0;
        f32x4 gv[2][2];
#pragma unroll
        for (int bj = 0; bj < 2; ++bj)
#pragma unroll
            for (int n = 0; n < 2; ++n) gv[bj][n] = *(const f32x4*)(gp + bj * HALF + n * 4);
#pragma unroll
        for (int ai = 0; ai < 2; ++ai)
#pragma unroll
            for (int m = 0; m < 4; ++m) { const size_t ro = (size_t)(row0 + ai * HALF + m * 16) * DM + col0;
#pragma unroll
                for (int bj = 0; bj < 2; ++bj)
#pragma unroll
                    for (int n = 0; n < 2; ++n) { const f32x4 xv = *(const f32x4*)(base + ro + bj * HALF + n * 4);
                        *(f32x4*)(out + ro + bj * HALF + n * 4) = xv + gv[bj][n] * acc[ai][bj][m][n]; } }
    }
};
struct EpiResB {
    static constexpr bool PERM = true;
    const float* base; bf16_t* outb; const float* gate;
    DI void operator()(const f32x4 (&acc)[2][2][4][2], const Unit& u, int wr, int wc, int fr, int fq) const {
        const int row0 = u.pm * BM + wr * 64 + fr, col0 = u.pn * BM + wc * 32 + 8 * fq;
        const float* gp = gate + (size_t)((u.pm * BM) >> 12) * NMODC + col0;
        f32x4 gv[2][2];
#pragma unroll
        for (int bj = 0; bj < 2; ++bj)
#pragma unroll
            for (int n = 0; n < 2; ++n) gv[bj][n] = *(const f32x4*)(gp + bj * HALF + n * 4);
#pragma unroll
        for (int ai = 0; ai < 2; ++ai)
#pragma unroll
            for (int m = 0; m < 4; ++m) { const size_t ro = (size_t)(row0 + ai * HALF + m * 16) * DM + col0;
#pragma unroll
                for (int bj = 0; bj < 2; ++bj) {
                    const f32x4 x0 = *(const f32x4*)(base + ro + bj * HALF) + gv[bj][0] * acc[ai][bj][m][0], x1 = *(const f32x4*)(base + ro + bj * HALF + 4) + gv[bj][1] * acc[ai][bj][m][1];
                    u32x4 w; w.x = pk2(x0.x, x0.y); w.y = pk2(x0.z, x0.w); w.z = pk2(x1.x, x1.y); w.w = pk2(x1.z, x1.w);
                    *(u32x4*)(outb + ro + bj * HALF) = w; } }
    }
};
struct EpiResFromB {
    static constexpr bool PERM = true;
    bf16_t* xb; const float* gate;
    DI void operator()(const f32x4 (&acc)[2][2][4][2], const Unit& u, int wr, int wc, int fr, int fq) const {
        const int row0 = u.pm * BM + wr * 64 + fr, col0 = u.pn * BM + wc * 32 + 8 * fq;
        const float* gp = gate + (size_t)((u.pm * BM) >> 12) * NMODC + col0;
        f32x4 gv[2][2];
#pragma unroll
        for (int bj = 0; bj < 2; ++bj)
#pragma unroll
            for (int n = 0; n < 2; ++n) gv[bj][n] = *(const f32x4*)(gp + bj * HALF + n * 4);
#pragma unroll
        for (int ai = 0; ai < 2; ++ai)
#pragma unroll
            for (int m = 0; m < 4; ++m) { const size_t ro = (size_t)(row0 + ai * HALF + m * 16) * DM + col0;
#pragma unroll
                for (int bj = 0; bj < 2; ++bj) {
                    const u32x4 q = *(const u32x4*)(xb + ro + bj * HALF);
                    const f32x4 b0 = {bflo(q.x), bfhi(q.x), bflo(q.y), bfhi(q.y)}, b1 = {bflo(q.z), bfhi(q.z), bflo(q.w), bfhi(q.w)};
                    const f32x4 x0 = b0 + gv[bj][0] * acc[ai][bj][m][0], x1 = b1 + gv[bj][1] * acc[ai][bj][m][1];
                    u32x4 w; w.x = pk2(x0.x, x0.y); w.y = pk2(x0.z, x0.w); w.z = pk2(x1.x, x1.y); w.w = pk2(x1.z, x1.w);
                    *(u32x4*)(xb + ro + bj * HALF) = w; } }
    }
};
}

template <int MAP>
DI void transpose_item(const float* W, int K, int N, unsigned char* ws, float* scr, int item, int lane) {
    const int nblk = N / 32, kb = item / nblk, nb = item % nblk, k0 = 64 * kb, n0 = 32 * nb;
#pragma unroll 8
    for (int i = 0; i < 32; ++i) { const int kk = 2 * i + (lane >> 5); scr[kk * 33 + (lane & 31)] = W[(size_t)(k0 + kk) * N + n0 + (lane & 31)]; }
    __builtin_amdgcn_wave_barrier();
    asm volatile("s_waitcnt lgkmcnt(0)" ::: "memory");
    const int c = lane & 7;
#pragma unroll
    for (int j = 0; j < 4; ++j) {
        const int nl = (lane >> 3) + 8 * j, n = n0 + nl; const float* s = scr + (8 * c) * 33 + nl;
        u32x4 o; o.x = pk2(s[0 * 33], s[1 * 33]); o.y = pk2(s[2 * 33], s[3 * 33]); o.z = pk2(s[4 * 33], s[5 * 33]); o.w = pk2(s[6 * 33], s[7 * 33]);
        bf16_t* dst;
        if (MAP == 0) {
            if (n < 2048) dst = (bf16_t*)(ws + OFF_WIN) + (size_t)n * K;
            else if (n < 2064) dst = (bf16_t*)(ws + OFF_WG) + (size_t)(n - 2048) * K;
            else if (n < 4112) dst = (bf16_t*)(ws + OFF_WIN) + (size_t)(n - 16) * K;
            else dst = (bf16_t*)(ws + OFF_WG) + (size_t)(16 + n - 4112) * K;
        } else if (MAP == 1) {
            dst = (bf16_t*)(ws + OFF_WOUT) + (size_t)n * K;
        } else if (MAP == 2) {
            const int up = n >= DFF, ff = up ? n - DFF : n;
            dst = (bf16_t*)(ws + OFF_WFF1) + (size_t)(256 * (ff >> 7) + 128 * up + (ff & 127)) * K;
        } else {
            dst = (bf16_t*)(ws + OFF_WFF2) + (size_t)n * K;
        }
        *(u32x4*)(dst + k0 + 8 * c) = o;
    }
    __builtin_amdgcn_wave_barrier();
    asm volatile("s_waitcnt lgkmcnt(0)" ::: "memory");
}

DI void phase0(const Params& p, unsigned char* smem) {
    const int tid = threadIdx.x, wave = tid >> 6, lane = tid & 63;
    float* sc = (float*)smem;
    float* red = (float*)(smem + 17 * 1024 * 4);
    float* modp = (float*)(p.ws + OFF_MOD);
    if (blockIdx.x < 192) {
        for (int idx = tid; idx < 17 * 1024; idx += 512) { const float v = idx < 16384 ? p.c[idx] : p.c_ctx[idx - 16384]; sc[idx] = siluf_(v); }
        __syncthreads();
        for (int item = blockIdx.x; item < 192; item += gridDim.x) {
            const int col = item * 32 + (lane & 31), kh = lane >> 5;
            float acc[17];
#pragma unroll
            for (int b = 0; b < 17; ++b) acc[b] = 0.f;
#pragma unroll 4
            for (int kk = 0; kk < 64; ++kk) {
                const int k = 128 * wave + 2 * kk + kh; const float wv = p.w_mod[(size_t)k * NMODC + col];
#pragma unroll
                for (int b = 0; b < 17; ++b) acc[b] += sc[b * 1024 + k] * wv;
            }
#pragma unroll
            for (int b = 0; b < 17; ++b) { acc[b] += __shfl_xor(acc[b], 32); if (lane < 32) red[(wave * 17 + b) * 32 + lane] = acc[b]; }
            __syncthreads();
            for (int idx = tid; idx < 17 * 32; idx += 512) { const int b = idx >> 5, cc = idx & 31; float s = p.b_mod[item * 32 + cc];
#pragma unroll
                for (int w = 0; w < 8; ++w) s += red[(w * 17 + b) * 32 + cc];
                modp[b * NMODC + item * 32 + cc] = s; }
            __syncthreads();
        }
    }
    __syncthreads();
    float* scr = (float*)(smem + wave * 8704);
    constexpr int I0 = 16 * 129, I1 = 16 * 32, I2 = 16 * 176, I3 = 44 * 32;
    const int gw = blockIdx.x * 8 + wave, NGW = gridDim.x * 8;
    for (int it = gw; it < I0 + I1 + I2 + I3; it += NGW) {
        int r = it;
        if (r < I0) { transpose_item<0>(p.w_in, 1024, 4128, p.ws, scr, r, lane); continue; } r -= I0;
        if (r < I1) { transpose_item<1>(p.w_out, 1024, 1024, p.ws, scr, r, lane); continue; } r -= I1;
        if (r < I2) { transpose_item<2>(p.w_ffn_in, 1024, 5632, p.ws, scr, r, lane); continue; } r -= I2;
        transpose_item<3>(p.w_ffn_out, 2816, 1024, p.ws, scr, r, lane);
    }
}

template <int MODE>
DI void norm_rows(const Params& p) {
    const int wave = threadIdx.x >> 6, lane = threadIdx.x & 63;
    const int gw = blockIdx.x * 8 + wave, NGW = gridDim.x * 8;
    const int nrows = MODE == 0 ? MTOT : NLAT;
    const float* modp = (const float*)(p.ws + OFF_MOD);
    const float* gain = MODE == 0 ? p.norm1 : (MODE == 1 ? p.norm2 : p.final_norm);
    f32x4 gn[4];
#pragma unroll
    for (int j = 0; j < 4; ++j) gn[j] = *(const f32x4*)(gain + 4 * lane + 256 * j);
    for (int row0 = gw; row0 < nrows; row0 += 2 * NGW) {
        const float* src[2]; int mb[2]; f32x4 v[2][4]; float s[2];
#pragma unroll
        for (int u = 0; u < 2; ++u) {
            const int row = row0 + u * NGW < nrows ? row0 + u * NGW : row0;
            if (MODE == 0) { if (row < NLAT) { src[u] = p.x + (size_t)row * DM; mb[u] = row >> 12; } else { src[u] = p.ctx + (size_t)(row - NLAT) * DM; mb[u] = 16; } }
            else { src[u] = p.out + (size_t)row * DM; mb[u] = row >> 12; }
#pragma unroll
            for (int j = 0; j < 4; ++j) v[u][j] = *(const f32x4*)(src[u] + 4 * lane + 256 * j);
        }
#pragma unroll
        for (int u = 0; u < 2; ++u) {
            const int row = row0 + u * NGW;
            if (row >= nrows) break;
            s[u] = 0.f;
#pragma unroll
            for (int j = 0; j < 4; ++j) s[u] += (v[u][j].x * v[u][j].x + v[u][j].y * v[u][j].y) + (v[u][j].z * v[u][j].z + v[u][j].w * v[u][j].w);
            const float rstd = rsqrtf(wave_sum(s[u]) * (1.f / DM) + EPS);
            if (MODE == 2) {
                float* dst = p.out + (size_t)row * DM;
#pragma unroll
                for (int j = 0; j < 4; ++j) *(f32x4*)(dst + 4 * lane + 256 * j) = v[u][j] * rstd * gn[j];
            } else {
                const float* mrow = modp + (size_t)mb[u] * NMODC + (MODE == 0 ? 0 : 3072);
                bf16_t* dst = (bf16_t*)(p.ws + OFF_A) + (MODE == 0 ? (size_t)0 : (size_t)NLAT * 1024) + (size_t)row * DM;
#pragma unroll
                for (int j = 0; j < 4; ++j) {
                    const f32x4 sh = *(const f32x4*)(mrow + 4 * lane + 256 * j), scl = *(const f32x4*)(mrow + 1024 + 4 * lane + 256 * j);
                    const f32x4 y = (v[u][j] * rstd * gn[j]) * (scl + 1.f) + sh;
                    u32x2 o; o.x = pk2(y.x, y.y); o.y = pk2(y.z, y.w);
                    *(u32x2*)(dst + 4 * lane + 256 * j) = o;
                }
            }
        }
    }
}

DI void norm_rows_b(const Params& p) {
    const int wave = threadIdx.x >> 6, lane = threadIdx.x & 63;
    const int gw = blockIdx.x * 8 + wave, NGW = gridDim.x * 8;
    const float* modp = (const float*)(p.ws + OFF_MOD);
    const bf16_t* X1 = (const bf16_t*)(p.ws + OFF_X1B); bf16_t* H2 = (bf16_t*)(p.ws + OFF_A) + (size_t)NLAT * 1024;
    f32x4 gn[2][2];
#pragma unroll
    for (int j = 0; j < 2; ++j) { gn[j][0] = *(const f32x4*)(p.norm2 + 8 * lane + 512 * j); gn[j][1] = *(const f32x4*)(p.norm2 + 8 * lane + 512 * j + 4); }
    for (int row0 = gw; row0 < NLAT; row0 += 4 * NGW) {
        u32x4 v[4][2];
#pragma unroll
        for (int u = 0; u < 4; ++u)
#pragma unroll
            for (int j = 0; j < 2; ++j) v[u][j] = *(const u32x4*)(X1 + (size_t)(row0 + u * NGW) * DM + 8 * lane + 512 * j);
#pragma unroll
        for (int u = 0; u < 4; ++u) {
            const int row = row0 + u * NGW;
            float f[2][8]; float s = 0.f;
#pragma unroll
            for (int j = 0; j < 2; ++j) { const u32x4 q = v[u][j];
                f[j][0] = bflo(q.x); f[j][1] = bfhi(q.x); f[j][2] = bflo(q.y); f[j][3] = bfhi(q.y); f[j][4] = bflo(q.z); f[j][5] = bfhi(q.z); f[j][6] = bflo(q.w); f[j][7] = bfhi(q.w);
#pragma unroll
                for (int e = 0; e < 8; ++e) s += f[j][e] * f[j][e]; }
            const float rstd = rsqrtf(wave_sum(s) * (1.f / DM) + EPS);
            const float* mrow = modp + (size_t)(row >> 12) * NMODC + 3072;
#pragma unroll
            for (int j = 0; j < 2; ++j) {
                const f32x4 sh0 = *(const f32x4*)(mrow + 8 * lane + 512 * j), sh1 = *(const f32x4*)(mrow + 8 * lane + 512 * j + 4);
                const f32x4 sc0 = *(const f32x4*)(mrow + 1024 + 8 * lane + 512 * j), sc1 = *(const f32x4*)(mrow + 1024 + 8 * lane + 512 * j + 4);
                const f32x4 x0 = {f[j][0], f[j][1], f[j][2], f[j][3]}, x1 = {f[j][4], f[j][5], f[j][6], f[j][7]};
                const f32x4 y0 = (x0 * rstd * gn[j][0]) * (sc0 + 1.f) + sh0, y1 = (x1 * rstd * gn[j][1]) * (sc1 + 1.f) + sh1;
                u32x4 o; o.x = pk2(y0.x, y0.y); o.y = pk2(y0.z, y0.w); o.z = pk2(y1.x, y1.y); o.w = pk2(y1.z, y1.w);
                *(u32x4*)(H2 + (size_t)row * DM + 8 * lane + 512 * j) = o;
            }
        }
    }
}

DI void final_norm_b(const Params& p) {
    const int wave = threadIdx.x >> 6, lane = threadIdx.x & 63;
    const int gw = blockIdx.x * 8 + wave, NGW = gridDim.x * 8;
    const bf16_t* X2 = (const bf16_t*)(p.ws + OFF_X1B);
    f32x4 gn[2][2];
#pragma unroll
    for (int j = 0; j < 2; ++j) { gn[j][0] = *(const f32x4*)(p.final_norm + 8 * lane + 512 * j); gn[j][1] = *(const f32x4*)(p.final_norm + 8 * lane + 512 * j + 4); }
    for (int row0 = gw; row0 < NLAT; row0 += 4 * NGW) {
        u32x4 v[4][2];
#pragma unroll
        for (int u = 0; u < 4; ++u)
#pragma unroll
            for (int j = 0; j < 2; ++j) v[u][j] = *(const u32x4*)(X2 + (size_t)(row0 + u * NGW) * DM + 8 * lane + 512 * j);
#pragma unroll
        for (int u = 0; u < 4; ++u) {
            const int row = row0 + u * NGW;
            f32x4 f[2][2]; float s = 0.f;
#pragma unroll
            for (int j = 0; j < 2; ++j) { const u32x4 q = v[u][j];
                f[j][0] = (f32x4){bflo(q.x), bfhi(q.x), bflo(q.y), bfhi(q.y)}; f[j][1] = (f32x4){bflo(q.z), bfhi(q.z), bflo(q.w), bfhi(q.w)};
                s += (f[j][0].x * f[j][0].x + f[j][0].y * f[j][0].y) + (f[j][0].z * f[j][0].z + f[j][0].w * f[j][0].w) + (f[j][1].x * f[j][1].x + f[j][1].y * f[j][1].y) + (f[j][1].z * f[j][1].z + f[j][1].w * f[j][1].w); }
            const float rstd = rsqrtf(wave_sum(s) * (1.f / DM) + EPS);
            float* dst = p.out + (size_t)row * DM + 8 * lane;
#pragma unroll
            for (int j = 0; j < 2; ++j) { *(f32x4*)(dst + 512 * j) = f[j][0] * rstd * gn[j][0]; *(f32x4*)(dst + 512 * j + 4) = f[j][1] * rstd * gn[j][1]; }
        }
    }
}

DI void gates_gemm(const Params& p) {
    const int wave = threadIdx.x >> 6, lane = threadIdx.x & 63, r = lane & 31, hh = lane >> 5;
    const int gw = blockIdx.x * 8 + wave, NGW = gridDim.x * 8;
    const bf16_t* H = (const bf16_t*)(p.ws + OFF_A); const bf16_t* WG = (const bf16_t*)(p.ws + OFF_WG);
    float* graw = (float*)(p.ws + OFF_GRAW);
    for (int rg = gw; rg < MTOT / 32; rg += NGW) {
        f32x16 acc; for (int i = 0; i < 16; ++i) acc[i] = 0.f;
        const bf16_t* ap = H + (size_t)(32 * rg + r) * DM + 8 * hh; const bf16_t* bp = WG + (size_t)r * DM + 8 * hh;
#pragma unroll 8
        for (int s = 0; s < 64; ++s) { const bf16x8 a = *(const bf16x8*)(ap + 16 * s), b = *(const bf16x8*)(bp + 16 * s); acc = MFMA32(a, b, acc); }
#pragma unroll
        for (int i = 0; i < 16; ++i) graw[(size_t)(32 * rg + crow(i, hh)) * 32 + r] = acc[i];
    }
}

DI void dn_conv_phase(const Params& p, unsigned char* smem) {
    const int lane = threadIdx.x & 63;
    int* ctr = (int*)smem;
    if (threadIdx.x == 0) *ctr = 0;
    __syncthreads();
    const bf16_t* P = (const bf16_t*)(p.ws + OFF_P); bf16_t* QKV = (bf16_t*)p.out;
    constexpr int SEG = 16;
    constexpr int NITEM = (MTOT / SEG) * 3;
    const int per_blk = (NITEM + (int)gridDim.x - 1) / (int)gridDim.x, base_item = per_blk * (int)blockIdx.x;
    for (;;) {
        int idx = 0; if (lane == 0) idx = atomicAdd(ctr, 1);
        idx = __builtin_amdgcn_readfirstlane(idx);
        const int item = base_item + idx;
        if (idx >= per_blk || item >= NITEM) break;
        const int seg = item / 3, part = item - seg * 3;
        const int row0 = seg * SEG; const int L = row0 < NLAT ? SEQ : CTXL; const int t0 = (row0 < NLAT ? row0 : row0 - NLAT) & (L - 1);
        const int ch = 8 * (lane + 64 * part);
        f32x2 w[5][4];
#pragma unroll
        for (int j = 0; j < 5; ++j) { const f32x4 a = *(const f32x4*)(p.dn_conv + j * 1536 + ch), b = *(const f32x4*)(p.dn_conv + j * 1536 + ch + 4);
            w[j][0] = (f32x2){a.x, a.y}; w[j][1] = (f32x2){a.z, a.w}; w[j][2] = (f32x2){b.x, b.y}; w[j][3] = (f32x2){b.z, b.w}; }
        const bf16_t* src = P + (size_t)row0 * P1W + ch;
        const u32x4 zero = {0u, 0u, 0u, 0u};
        u32x4 rows[SEG + 4];
#pragma unroll
        for (int q = 0; q < SEG + 4; ++q) { const int t = t0 + q - 2; rows[q] = (t >= 0 && t < L) ? *(const u32x4*)(src + (ptrdiff_t)(q - 2) * P1W) : zero; }
        f32x2 ring[5][4];
#pragma unroll
        for (int q = 0; q < 4; ++q) { const u32x4 u = rows[q];
            ring[q][0] = (f32x2){bflo(u.x), bfhi(u.x)}; ring[q][1] = (f32x2){bflo(u.y), bfhi(u.y)}; ring[q][2] = (f32x2){bflo(u.z), bfhi(u.z)}; ring[q][3] = (f32x2){bflo(u.w), bfhi(u.w)}; }
#pragma unroll
        for (int tt = 0; tt < SEG; ++tt) {
            { const u32x4 u = rows[tt + 4]; const int sl = (tt + 4) % 5;
              ring[sl][0] = (f32x2){bflo(u.x), bfhi(u.x)}; ring[sl][1] = (f32x2){bflo(u.y), bfhi(u.y)}; ring[sl][2] = (f32x2){bflo(u.z), bfhi(u.z)}; ring[sl][3] = (f32x2){bflo(u.w), bfhi(u.w)}; }
            f32x2 o2[4];
#pragma unroll
            for (int e = 0; e < 4; ++e) o2[e] = w[0][e] * ring[tt % 5][e];
#pragma unroll
            for (int j = 1; j < 5; ++j)
#pragma unroll
                for (int e = 0; e < 4; ++e) o2[e] += w[j][e] * ring[(tt + j) % 5][e];
            float o[8];
#pragma unroll
            for (int e = 0; e < 4; ++e) { o[2 * e] = siluf_(o2[e].x); o[2 * e + 1] = siluf_(o2[e].y); }
            if (part < 2) {
                float ss = 0.f;
#pragma unroll
                for (int e = 0; e < 8; ++e) ss += o[e] * o[e];
                ss += __shfl_xor(ss, 1); ss += __shfl_xor(ss, 2); ss += __shfl_xor(ss, 4); ss += __shfl_xor(ss, 8);
                const float sc = rsqrtf(ss + EPS) * (part == 0 ? 0.08838834764831845f : 1.f);
#pragma unroll
                for (int e = 0; e < 8; ++e) o[e] *= sc;
            }
            u32x4 ov; ov.x = pk2(o[0], o[1]); ov.y = pk2(o[2], o[3]); ov.z = pk2(o[4], o[5]); ov.w = pk2(o[6], o[7]);
            *(u32x4*)(QKV + (size_t)(row0 + tt) * 1536 + ch) = ov;
        }
    }
}

DI int scan_row(int type, int dir, int b, int seg, int chunk, int i) {
    const int s = chunk * 64 + i;
    if (seg == 0) { const int pos = dir ? 255 - s : s; return NLAT + b * CTXL + pos; }
    const int pos = dir ? 4095 - s : s;
    const int tok = type ? ((pos & 63) * 64 + (pos >> 6)) : pos;
    return b * SEQ + tok;
}
constexpr int LQ = 0, LK = 17408, LV = 34816, LW = 52224, LKT = 69632, LPM = 88064, LAM = 97280, LU = 114688, LSM = 148480;
constexpr int SCAN_LDS = 156672;
constexpr int ST = 136, STT = 72;

#define LDS_BARRIER() do { asm volatile("s_waitcnt lgkmcnt(0)" ::: "memory"); __builtin_amdgcn_s_barrier(); asm volatile("" ::: "memory"); } while (0)
constexpr int DQ = 0, DK = 17408, DVW = 34816, DKT = 52224, DVT = 70656, DP = 89088, DAD = 98304, DA10 = 107520, DT00 = 110080, DT11 = 112640, DSM = 115200, DSM2 = 117248, DM1 = 119296, DM2T = 124416, DM3 = 129536;
static_assert(DM3 + 5120 <= SCAN_LDS, "scan LDS");
template <bool CONS>
DI void dn_chain_role(const Params& p, unsigned char* smem, int dir, int b, int h) {
    const int tid0 = threadIdx.x, wave = __builtin_amdgcn_readfirstlane(tid0 >> 6), lane0 = tid0 & 63;
    bf16_t* sQ = (bf16_t*)(smem + DQ); bf16_t* sK = (bf16_t*)(smem + DK); bf16_t* sV = (bf16_t*)(smem + DVW);
    bf16_t* sKT = (bf16_t*)(smem + DKT); bf16_t* sVT = (bf16_t*)(smem + DVT); bf16_t* sP = (bf16_t*)(smem + DP);
    float* sAd = (float*)(smem + DAD); bf16_t* sA10 = (bf16_t*)(smem + DA10); bf16_t* sT00 = (bf16_t*)(smem + DT00); bf16_t* sT11 = (bf16_t*)(smem + DT11);
    bf16_t* sM1 = (bf16_t*)(smem + DM1);
    const bf16_t* QKV = (const bf16_t*)p.out; const float* graw = (const float*)(p.ws + OFF_GRAW);
    bf16_t* O = (bf16_t*)(p.ws + OFF_A) + (size_t)dir * NLAT * 1024;
    const float a_coef = expf(p.dn_a_log[dir * 4 + h]), dtb = p.dn_dt_bias[dir * 4 + h];
    f32x16 S[4];
    if (CONS) {
#pragma unroll
        for (int kt = 0; kt < 4; ++kt) for (int i = 0; i < 16; ++i) S[kt][i] = 0.f;
    }
    for (int i = tid0; i < (2560 * 2) / 4; i += 512) ((unsigned*)sT00)[i] = 0u;
    for (int i = tid0; i < (2560 * 6) / 4; i += 512) ((unsigned*)sM1)[i] = 0u;
    for (int i = tid0; i < 9216 / 4; i += 512) ((unsigned*)sP)[i] = 0u;
    u32x4 pq[4], pk[4], pv[4]; float pbr = 0.f, par = 0.f; int prow = 0;
    if (!CONS) {
#pragma unroll
        for (int it = 0; it < 4; ++it) {
            const int idx = tid0 - 256 + 256 * it, i = idx >> 4, c8 = idx & 15;
            const bf16_t* src = QKV + (size_t)scan_row(0, dir, b, 0, 0, i) * 1536 + h * 128 + c8 * 8;
            pq[it] = *(const u32x4*)src; pk[it] = *(const u32x4*)(src + 512); pv[it] = *(const u32x4*)(src + 1024);
        }
    }
    if (!CONS && wave == 5) { prow = scan_row(0, dir, b, 0, 0, lane0); pbr = graw[(size_t)prow * 32 + dir * 4 + h]; par = graw[(size_t)prow * 32 + 8 + dir * 4 + h]; }
    __syncthreads();

    for (int ck = 0; ck < 68; ++ck) {
        int lane = lane0; asm volatile("" : "+v"(lane));
        const int tid = (wave << 6) | lane, r = lane & 31, hh = lane >> 5;
        const int seg = ck >= 4 ? 1 : 0;
        float* sG = (float*)(smem + ((ck & 1) ? DSM2 : DSM)); float* sBeta = sG + 64; float* sEG = sG + 128; float* sDL = sG + 192; int* sRow = (int*)(sG + 320);
        if (!CONS) {
#pragma unroll
            for (int it = 0; it < 4; ++it) {
                const int idx = tid - 256 + 256 * it, i = idx >> 4, c8 = idx & 15;
                *(u32x4*)(sQ + i * ST + c8 * 8) = pq[it]; *(u32x4*)(sK + i * ST + c8 * 8) = pk[it]; *(u32x4*)(sV + i * ST + c8 * 8) = pv[it];
            }
        }
        if (!CONS && wave == 5) {
            const float beta = sigmoidf_(pbr), g = -a_coef * softplusf_(par + dtb);
            float G = g;
#pragma unroll
            for (int o = 1; o < 64; o <<= 1) { const float t = __shfl_up(G, o); if (lane >= o) G += t; }
            const float Gl = __shfl(G, 63), eG = expf(G);
            sG[lane] = G * 1.4426950408889634f; sBeta[lane] = beta; sEG[lane] = eG; sDL[lane] = expf(Gl - G); sRow[lane] = prow;
        }
        if (!CONS && ck + 1 < 68) {
            const int nseg = (ck + 1) >= 4 ? 1 : 0, nchunk = nseg ? ck + 1 - 4 : ck + 1;
#pragma unroll
            for (int it = 0; it < 4; ++it) {
                const int idx = tid - 256 + 256 * it, i = idx >> 4, c8 = idx & 15;
                const bf16_t* src = QKV + (size_t)scan_row(0, dir, b, nseg, nchunk, i) * 1536 + h * 128 + c8 * 8;
                pq[it] = *(const u32x4*)src; pk[it] = *(const u32x4*)(src + 512); pv[it] = *(const u32x4*)(src + 1024);
            }
            if (!CONS && wave == 5) { prow = scan_row(0, dir, b, nseg, nchunk, lane); pbr = graw[(size_t)prow * 32 + dir * 4 + h]; par = graw[(size_t)prow * 32 + 8 + dir * 4 + h]; }
        }
        LDS_BARRIER();
        if ((CONS && (wave == 1 || wave == 3)) || (!CONS && (wave == 5 || wave == 7))) {
            const bool isA10 = CONS && wave == 1;
            const int w3 = CONS ? 1 : (wave == 5 ? 0 : 2), ti = (w3 + 1) >> 1, tj = w3 >> 1;
            const bf16_t* am = isA10 ? sK : sQ;
            f32x16 acc; for (int i = 0; i < 16; ++i) acc[i] = 0.f;
#pragma unroll
            for (int s = 0; s < 8; ++s) { const bf16x8 a = load_nat(am, ST, 32 * ti + r, 16 * s + 8 * hh), bb = load_nat(sK, ST, 32 * tj + r, 16 * s + 8 * hh); acc = MFMA32(a, bb, acc); }
            const int j = 32 * tj + r; const float Gj = sG[j];
            if (isA10) {
#pragma unroll
                for (int g4 = 0; g4 < 4; ++g4) { const int il0 = 8 * g4 + 4 * hh; const f32x4 gi = *(const f32x4*)(sG + 32 + il0), bi = *(const f32x4*)(sBeta + 32 + il0);
#pragma unroll
                    for (int t = 0; t < 4; ++t) sA10[(il0 + t) * 40 + r] = f2bf(acc[4 * g4 + t] * bi[t] * __builtin_amdgcn_exp2f(gi[t] - Gj)); }
            } else {
#pragma unroll
                for (int g4 = 0; g4 < 4; ++g4) { const int i0 = 32 * ti + 8 * g4 + 4 * hh; const f32x4 gi = *(const f32x4*)(sG + i0);
#pragma unroll
                    for (int t = 0; t < 4; ++t) sP[(i0 + t) * STT + j] = f2bf(i0 + t >= j ? acc[4 * g4 + t] * __builtin_amdgcn_exp2f(gi[t] - Gj) : 0.f); }
            }
        }
        if (wave != 4 && wave != 6) {
            const int tq = (wave < 4 ? wave : (wave == 5 ? 4 : 5)) * 64 + lane;
#pragma unroll
            for (int it = 0; it < 3; ++it) {
                const int item = tq + 384 * it;
                if (item < 1024) {
                    const int m = item >> 9, rem = item & 511, i2 = rem & 31, c8 = rem >> 5;
                    const bf16_t* srcp = (m ? sV : sK) + (2 * i2) * ST + c8 * 8;
                    const u32x4 a = *(const u32x4*)srcp, bq = *(const u32x4*)(srcp + ST);
                    unsigned* d = (unsigned*)((m ? sVT : sKT) + (8 * c8) * STT) + i2;
                    d[0 * (STT / 2)] = __builtin_amdgcn_perm(bq.x, a.x, 0x05040100u); d[1 * (STT / 2)] = __builtin_amdgcn_perm(bq.x, a.x, 0x07060302u);
                    d[2 * (STT / 2)] = __builtin_amdgcn_perm(bq.y, a.y, 0x05040100u); d[3 * (STT / 2)] = __builtin_amdgcn_perm(bq.y, a.y, 0x07060302u);
                    d[4 * (STT / 2)] = __builtin_amdgcn_perm(bq.z, a.z, 0x05040100u); d[5 * (STT / 2)] = __builtin_amdgcn_perm(bq.z, a.z, 0x07060302u);
                    d[6 * (STT / 2)] = __builtin_amdgcn_perm(bq.w, a.w, 0x05040100u); d[7 * (STT / 2)] = __builtin_amdgcn_perm(bq.w, a.w, 0x07060302u);
                }
            }
        }
        f32x16 o[2], ks[2];
        if (CONS) {
#pragma unroll
            for (int mi = 0; mi < 2; ++mi) for (int i = 0; i < 16; ++i) { o[mi][i] = 0.f; ks[mi][i] = 0.f; }
#pragma unroll
            for (int kt = 0; kt < 4; ++kt)
#pragma unroll
                for (int s = 0; s < 2; ++s) { const bf16x8 bf = pack_step(S[kt], s);
#pragma unroll
                    for (int mi = 0; mi < 2; ++mi) { o[mi] = MFMA32(load_perm(sQ, ST, 32 * mi + r, 32 * kt + 16 * s, hh), bf, o[mi]);
                                                     ks[mi] = MFMA32(load_perm(sK, ST, 32 * mi + r, 32 * kt + 16 * s, hh), bf, ks[mi]); } }
        } else if (wave == 4 || wave == 6) {
            const int blk = wave == 4 ? 0 : 1;
            bf16_t* sM1b = (bf16_t*)(smem + DM1 + 2560 * blk); bf16_t* sM2Tb = (bf16_t*)(smem + DM2T + 2560 * blk); bf16_t* sM3b = (bf16_t*)(smem + DM3 + 2560 * blk);
            bf16_t* Tb = blk ? sT11 : sT00;
            {
                f32x16 acc; for (int i = 0; i < 16; ++i) acc[i] = 0.f;
#pragma unroll
                for (int s = 0; s < 8; ++s) { const bf16x8 a = load_nat(sK, ST, 32 * blk + r, 16 * s + 8 * hh); acc = MFMA32(a, a, acc); }
                const float Gj = sG[32 * blk + r];
                const int m1col = r < 16 ? r : 32 + (r & 7);
#pragma unroll
                for (int g4 = 0; g4 < 4; ++g4) { const int il0 = 8 * g4 + 4 * hh; const f32x4 gi = *(const f32x4*)(sG + 32 * blk + il0), bi = *(const f32x4*)(sBeta + 32 * blk + il0);
#pragma unroll
                    for (int t = 0; t < 4; ++t) { const int il = il0 + t; const float v = il > r ? acc[4 * g4 + t] * bi[t] * __builtin_amdgcn_exp2f(gi[t] - Gj) : 0.f;
                        sAd[(blk * 32 + il) * 36 + r] = v;
                        if (g4 >= 2) sM1b[(il - 16) * 40 + m1col] = f2bf(v); } }
            }
            asm volatile("s_waitcnt lgkmcnt(0)" ::: "memory");
            __builtin_amdgcn_wave_barrier();
            const int sub = (lane >> 4) & 1, c = lane & 15;
            const float* Ab = sAd + (blk * 32 + 16 * sub) * 36 + 16 * sub;
            f32x4 ar[16][4];
#pragma unroll
            for (int i = 1; i < 16; ++i)
#pragma unroll
                for (int q = 0; q < (i + 3) / 4; ++q) ar[i][q] = *(const f32x4*)(Ab + i * 36 + 4 * q);
            float x[16];
#pragma unroll
            for (int i = 0; i < 16; ++i) {
                float acc = (i == c) ? 1.f : 0.f;
#pragma unroll
                for (int j = 0; j < i; ++j) acc = fnma_(ar[i][j >> 2][j & 3], x[j], acc);
                x[i] = acc;
            }
            { bf16_t* Tq = Tb + (16 * sub) * 40 + 16 * sub + c;
#pragma unroll
              for (int i = 0; i < 16; ++i) Tq[i * 40] = f2bf(x[i]); }
            if (sub == 0) {
                u32x4 xl, xh;
                xl.x = pk2(x[0], x[1]); xl.y = pk2(x[2], x[3]); xl.z = pk2(x[4], x[5]); xl.w = pk2(x[6], x[7]);
                xh.x = pk2(x[8], x[9]); xh.y = pk2(x[10], x[11]); xh.z = pk2(x[12], x[13]); xh.w = pk2(x[14], x[15]);
                *(u32x4*)(sM2Tb + c * 40) = xl; *(u32x4*)(sM2Tb + c * 40 + 8) = xh;
            } else {
#pragma unroll
                for (int i = 0; i < 16; ++i) sM3b[i * 40 + c] = f2bf(x[i]);
            }
            asm volatile("s_waitcnt lgkmcnt(0)" ::: "memory");
            __builtin_amdgcn_wave_barrier();
            f32x16 X1; for (int i = 0; i < 16; ++i) X1[i] = 0.f;
            X1 = MFMA32(load_nat(sM1b, 40, r, 8 * hh), load_nat(sM2Tb, 40, r, 8 * hh), X1);
            f32x16 L1; for (int i = 0; i < 16; ++i) L1[i] = 0.f;
            L1 = MFMA32(load_perm(sM3b, 40, r, 0, hh), pack_step(X1, 0), L1);
            if (r < 16) {
#pragma unroll
                for (int t = 0; t < 8; ++t) Tb[(16 + crow(t, hh)) * 40 + r] = f2bf(-L1[t]);
            }
        }
        LDS_BARRIER();
        if (CONS) {
            f32x16 R[2];
#pragma unroll
            for (int mi = 0; mi < 2; ++mi)
#pragma unroll
                for (int g4 = 0; g4 < 4; ++g4) {
                    const int j0 = 32 * mi + 8 * g4 + 4 * hh;
                    const f32x4 be = *(const f32x4*)(sBeta + j0), eg = *(const f32x4*)(sEG + j0);
                    const u32x2 vv = *(const u32x2*)(sVT + (32 * wave + r) * STT + j0);
                    const float v0 = bflo(vv.x), v1 = bfhi(vv.x), v2 = bflo(vv.y), v3 = bfhi(vv.y);
                    R[mi][4 * g4 + 0] = be.x * (v0 - eg.x * ks[mi][4 * g4 + 0]); R[mi][4 * g4 + 1] = be.y * (v1 - eg.y * ks[mi][4 * g4 + 1]);
                    R[mi][4 * g4 + 2] = be.z * (v2 - eg.z * ks[mi][4 * g4 + 2]); R[mi][4 * g4 + 3] = be.w * (v3 - eg.w * ks[mi][4 * g4 + 3]);
                    o[mi][4 * g4 + 0] *= eg.x; o[mi][4 * g4 + 1] *= eg.y; o[mi][4 * g4 + 2] *= eg.z; o[mi][4 * g4 + 3] *= eg.w;
                }
            f32x16 vn[2], tmp;
#pragma unroll
            for (int i = 0; i < 16; ++i) { vn[0][i] = 0.f; vn[1][i] = 0.f; tmp[i] = 0.f; }
#pragma unroll
            for (int s = 0; s < 2; ++s) vn[0] = MFMA32(load_perm(sT00, 40, r, 16 * s, hh), pack_step(R[0], s), vn[0]);
#pragma unroll
            for (int s = 0; s < 2; ++s) tmp = MFMA32(load_perm(sA10, 40, r, 16 * s, hh), pack_step(vn[0], s), tmp);
#pragma unroll
            for (int i = 0; i < 16; ++i) R[1][i] -= tmp[i];
#pragma unroll
            for (int s = 0; s < 2; ++s) vn[1] = MFMA32(load_perm(sT11, 40, r, 16 * s, hh), pack_step(R[1], s), vn[1]);
#pragma unroll
            for (int ci = 0; ci < 2; ++ci)
#pragma unroll
                for (int s = 0; s < 2; ++s) { const bf16x8 bf = pack_step(vn[ci], s);
#pragma unroll
                    for (int mi = 0; mi < 2; ++mi) o[mi] = MFMA32(load_perm(sP, STT, 32 * mi + r, 32 * ci + 16 * s, hh), bf, o[mi]); }
            const float eGl = sEG[63];
#pragma unroll
            for (int kt = 0; kt < 4; ++kt) for (int i = 0; i < 16; ++i) S[kt][i] *= eGl;
#pragma unroll
            for (int mi = 0; mi < 2; ++mi)
#pragma unroll
                for (int g4 = 0; g4 < 4; ++g4) { const f32x4 dl = *(const f32x4*)(sDL + 32 * mi + 8 * g4 + 4 * hh);
                    vn[mi][4 * g4 + 0] *= dl.x; vn[mi][4 * g4 + 1] *= dl.y; vn[mi][4 * g4 + 2] *= dl.z; vn[mi][4 * g4 + 3] *= dl.w; }
#pragma unroll
            for (int ci = 0; ci < 2; ++ci)
#pragma unroll
                for (int s = 0; s < 2; ++s) { const bf16x8 bf = pack_step(vn[ci], s);
#pragma unroll
                    for (int kt = 0; kt < 4; ++kt) S[kt] = MFMA32(load_perm(sKT, STT, 32 * kt + r, 32 * ci + 16 * s, hh), bf, S[kt]); }
            if (seg) {
#pragma unroll
                for (int mi = 0; mi < 2; ++mi)
#pragma unroll
                    for (int g4 = 0; g4 < 4; ++g4) { const int4 rw = *(const int4*)(sRow + 32 * mi + 8 * g4 + 4 * hh); const unsigned cb = (unsigned)(h * 128 + 32 * wave + r);
                        O[(unsigned)rw.x * 1024u + cb] = f2bf(o[mi][4 * g4 + 0]); O[(unsigned)rw.y * 1024u + cb] = f2bf(o[mi][4 * g4 + 1]);
                        O[(unsigned)rw.z * 1024u + cb] = f2bf(o[mi][4 * g4 + 2]); O[(unsigned)rw.w * 1024u + cb] = f2bf(o[mi][4 * g4 + 3]); }
            }
        }
    }
}
DI void dn_chain(const Params& p, unsigned char* smem, int dir, int b, int h) {
    if (__builtin_amdgcn_readfirstlane(threadIdx.x >> 6) < 4) dn_chain_role<true>(p, smem, dir, b, h); else dn_chain_role<false>(p, smem, dir, b, h);
}

template <bool CONS>
DI void ml_chain_role(const Params& p, unsigned char* smem, int dir, int b, int h) {
    const int tid0 = threadIdx.x, wave = __builtin_amdgcn_readfirstlane(tid0 >> 6), lane0 = tid0 & 63;
    bf16_t* sQ = (bf16_t*)(smem + LQ); bf16_t* sK = (bf16_t*)(smem + LK); bf16_t* sKT = (bf16_t*)(smem + LKT); bf16_t* sS = (bf16_t*)(smem + LPM);
    const bf16_t* P = (const bf16_t*)(p.ws + OFF_P) + (size_t)MTOT * P1W; const float* graw = (const float*)(p.ws + OFF_GRAW);
    bf16_t* O = (bf16_t*)(p.ws + OFF_A) + (size_t)dir * NLAT * 1024;
    const float igb = p.ml_ig_bias[dir * 4 + h], fgb = p.ml_fg_bias[dir * 4 + h];
    constexpr float KSC = 0.08838834764831845f;
    f32x16 C[4];
    if (CONS) {
#pragma unroll
        for (int kt = 0; kt < 4; ++kt) for (int i = 0; i < 16; ++i) C[kt][i] = 0.f;
    }
    float mstate = 0.f;
    if (tid0 < 128) ((float*)(smem + LSM) + 448)[tid0] = 0.f;
    u32x4 pq[4], pk[4]; float pig = 0.f, pfr = 0.f; int prow = 0;
    unsigned short pvv[2][2][8];
    if (!CONS) {
#pragma unroll
        for (int it = 0; it < 4; ++it) {
            const int idx = tid0 - 256 + 256 * it, i = idx >> 4, c8 = idx & 15;
            const bf16_t* src = P + (size_t)scan_row(1, dir, b, 0, 0, i) * P2W + 512 + h * 128 + c8 * 8;
            pq[it] = *(const u32x4*)src; pk[it] = *(const u32x4*)(src + 512);
        }
        if (wave == 5) { prow = scan_row(1, dir, b, 0, 0, lane0); pig = graw[(size_t)prow * 32 + 16 + dir * 4 + h]; pfr = graw[(size_t)prow * 32 + 24 + dir * 4 + h]; }
    } else {
#pragma unroll
        for (int ci = 0; ci < 2; ++ci)
#pragma unroll
            for (int s = 0; s < 2; ++s)
#pragma unroll
                for (int e = 0; e < 8; ++e) { const int row = scan_row(1, dir, b, 0, 0, 32 * ci + 16 * s + 8 * (lane0 >> 5) + e);
                    pvv[ci][s][e] = P[(size_t)row * P2W + 512 + 1024 + h * 128 + 32 * wave + (lane0 & 31)]; }
    }
    __syncthreads();

    for (int ck = 0; ck < 68; ++ck) {
        int lane = lane0; asm volatile("" : "+v"(lane));
        const int tid = (wave << 6) | lane, r = lane & 31, hh = lane >> 5;
        const int seg = ck >= 4 ? 1 : 0;
        const int nseg = (ck + 1) >= 4 ? 1 : 0, nchunk = nseg ? ck + 1 - 4 : ck + 1;
        float* sAj = (float*)(smem + LSM + ((ck & 1) ? 4096 : 0)); float* sMi = sAj + 64; float* sWin = sAj + 128; float* sFloor = sAj + 192; float* sWtok = sAj + 256; float* sRden = sAj + 320;
        int* sRow = (int*)(sAj + 384); float* sN = sAj + 448; float* sCs = sAj + 576;
        float* sNw = (float*)(smem + LSM + ((ck & 1) ? 0 : 4096)) + 448;
        bf16x8 vf[2][2];
        if (!CONS) {
#pragma unroll
            for (int it = 0; it < 4; ++it) {
                const int idx = tid - 256 + 256 * it, i = idx >> 4, c8 = idx & 15;
                *(u32x4*)(sQ + i * ST + c8 * 8) = pq[it]; *(u32x4*)(sK + i * ST + c8 * 8) = pk[it];
            }
            if (wave == 5) {
                const float ig = pig + igb, fr = pfr + fgb;
                const float lf = -softplusf_(-fr);
                float bc = lf;
#pragma unroll
                for (int o = 1; o < 64; o <<= 1) { const float t = __shfl_up(bc, o); if (lane >= o) bc += t; }
                const float blast = __shfl(bc, 63);
                const float a = ig - bc;
                float cm = a;
#pragma unroll
                for (int o = 1; o < 64; o <<= 1) { const float t = __shfl_up(cm, o); if (lane >= o) cm = fmaxf(cm, t); }
                const float amax = __shfl(cm, 63);
                const float Mall = fmaxf(mstate, amax), Mi = fmaxf(mstate, cm);
                sAj[lane] = a; sMi[lane] = Mi; sWin[lane] = expf(mstate - Mi); sFloor[lane] = expf(-(bc + Mi)); sWtok[lane] = expf(a - Mall) * KSC; sRow[lane] = prow;
                if (lane == 0) sCs[0] = expf(mstate - Mall);
                mstate = blast + Mall;
            }
            if (ck + 1 < 68) {
#pragma unroll
                for (int it = 0; it < 4; ++it) {
                    const int idx = tid - 256 + 256 * it, i = idx >> 4, c8 = idx & 15;
                    const bf16_t* src = P + (size_t)scan_row(1, dir, b, nseg, nchunk, i) * P2W + 512 + h * 128 + c8 * 8;
                    pq[it] = *(const u32x4*)src; pk[it] = *(const u32x4*)(src + 512);
                }
                if (wave == 5) { prow = scan_row(1, dir, b, nseg, nchunk, lane); pig = graw[(size_t)prow * 32 + 16 + dir * 4 + h]; pfr = graw[(size_t)prow * 32 + 24 + dir * 4 + h]; }
            }
        } else {
#pragma unroll
            for (int ci = 0; ci < 2; ++ci)
#pragma unroll
                for (int s = 0; s < 2; ++s)
#pragma unroll
                    for (int e = 0; e < 8; ++e) vf[ci][s][e] = (short)pvv[ci][s][e];
            if (ck + 1 < 68) {
                const int row0n = scan_row(1, dir, b, nseg, nchunk, 0), rstr = scan_row(1, dir, b, nseg, nchunk, 1) - row0n;
                const long long estr = (long long)rstr * P2W;
                const bf16_t* vb = P + (long long)row0n * P2W + (long long)(8 * hh) * estr + (512 + 1024 + h * 128 + 32 * wave + r);
#pragma unroll
                for (int ci = 0; ci < 2; ++ci)
#pragma unroll
                    for (int s = 0; s < 2; ++s)
#pragma unroll
                        for (int e = 0; e < 8; ++e) pvv[ci][s][e] = vb[(long long)(32 * ci + 16 * s + e) * estr];
            }
        }
        LDS_BARRIER();
        f32x16 o[2];
        if (!CONS) {
            const int w4 = wave & 3, ti = w4 >> 1, tj = w4 & 1;
            f32x16 acc; for (int i = 0; i < 16; ++i) acc[i] = 0.f;
#pragma unroll
            for (int s = 0; s < 8; ++s) { const bf16x8 a = load_nat(sQ, ST, 32 * ti + r, 16 * s + 8 * hh), bb = load_nat(sK, ST, 32 * tj + r, 16 * s + 8 * hh); acc = MFMA32(a, bb, acc); }
            const int j = 32 * tj + r; const float aj = sAj[j];
#pragma unroll
            for (int i16 = 0; i16 < 16; ++i16) { const int i = 32 * ti + crow(i16, hh); sS[i * STT + j] = f2bf(i >= j ? acc[i16] * KSC * __expf(aj - sMi[i]) : 0.f); }
            const int t = tid - 256;
            {
#pragma unroll
              for (int it = 0; it < 2; ++it) { const int item = t + 256 * it, i2 = item & 31, c8 = item >> 5;
                  const float da = sWtok[2 * i2], db = sWtok[2 * i2 + 1];
                  const bf16_t* srcp = sK + (2 * i2) * ST + c8 * 8;
                  const u32x4 ka = *(const u32x4*)srcp, kb = *(const u32x4*)(srcp + ST);
                  unsigned* d = (unsigned*)(sKT + (8 * c8) * STT) + i2;
                  d[0 * (STT / 2)] = pk2(bflo(ka.x) * da, bflo(kb.x) * db); d[1 * (STT / 2)] = pk2(bfhi(ka.x) * da, bfhi(kb.x) * db);
                  d[2 * (STT / 2)] = pk2(bflo(ka.y) * da, bflo(kb.y) * db); d[3 * (STT / 2)] = pk2(bfhi(ka.y) * da, bfhi(kb.y) * db);
                  d[4 * (STT / 2)] = pk2(bflo(ka.z) * da, bflo(kb.z) * db); d[5 * (STT / 2)] = pk2(bfhi(ka.z) * da, bfhi(kb.z) * db);
                  d[6 * (STT / 2)] = pk2(bflo(ka.w) * da, bflo(kb.w) * db); d[7 * (STT / 2)] = pk2(bfhi(ka.w) * da, bfhi(kb.w) * db); } }
        } else {
#pragma unroll
            for (int mi = 0; mi < 2; ++mi) for (int i = 0; i < 16; ++i) o[mi][i] = 0.f;
#pragma unroll
            for (int kt = 0; kt < 4; ++kt)
#pragma unroll
                for (int s = 0; s < 2; ++s) { const bf16x8 bf = pack_step(C[kt], s);
#pragma unroll
                    for (int mi = 0; mi < 2; ++mi) o[mi] = MFMA32(load_perm(sQ, ST, 32 * mi + r, 32 * kt + 16 * s, hh), bf, o[mi]); }
#pragma unroll
            for (int mi = 0; mi < 2; ++mi)
#pragma unroll
                for (int i = 0; i < 16; ++i) o[mi][i] *= sWin[32 * mi + crow(i, hh)];
        }
        LDS_BARRIER();
        if (!CONS) {
            const int t = tid - 256;
            { const int i = t >> 2, part = t & 3; float qn = 0.f, rs = 0.f;
#pragma unroll
              for (int q = 0; q < 4; ++q) { const u32x4 qv = *(const u32x4*)(sQ + i * ST + part * 32 + 8 * q);
                  const f32x4 n0 = *(const f32x4*)(sN + part * 32 + 8 * q), n1 = *(const f32x4*)(sN + part * 32 + 8 * q + 4);
                  qn += (bflo(qv.x) * n0.x + bfhi(qv.x) * n0.y) + (bflo(qv.y) * n0.z + bfhi(qv.y) * n0.w) + (bflo(qv.z) * n1.x + bfhi(qv.z) * n1.y) + (bflo(qv.w) * n1.z + bfhi(qv.w) * n1.w); }
#pragma unroll
              for (int q = 0; q < 2; ++q) { const u32x4 sv = *(const u32x4*)(sS + i * STT + part * 16 + 8 * q);
                  rs += (bflo(sv.x) + bfhi(sv.x)) + (bflo(sv.y) + bfhi(sv.y)) + (bflo(sv.z) + bfhi(sv.z)) + (bflo(sv.w) + bfhi(sv.w)); }
              qn += __shfl_xor(qn, 1); qn += __shfl_xor(qn, 2); rs += __shfl_xor(rs, 1); rs += __shfl_xor(rs, 2);
              if (part == 0) { const float den = sWin[i] * qn + rs; sRden[i] = 1.f / fmaxf(fabsf(den), sFloor[i]); } }
            if (wave < 6) {
                const int k = t; float acc = sCs[0] * sN[k];
#pragma unroll
                for (int q = 0; q < 8; ++q) { const u32x4 kv = *(const u32x4*)(sKT + k * STT + 8 * q);
                    acc += (bflo(kv.x) + bfhi(kv.x)) + (bflo(kv.y) + bfhi(kv.y)) + (bflo(kv.z) + bfhi(kv.z)) + (bflo(kv.w) + bfhi(kv.w)); }
                sNw[k] = acc;
            }
        } else {
#pragma unroll
            for (int ci = 0; ci < 2; ++ci)
#pragma unroll
                for (int s = 0; s < 2; ++s)
#pragma unroll
                    for (int mi = 0; mi < 2; ++mi) o[mi] = MFMA32(load_nat(sS, STT, 32 * mi + r, 32 * ci + 16 * s + 8 * hh), vf[ci][s], o[mi]);
        }
        LDS_BARRIER();
        const float cs = sCs[0];
        if (CONS) {
            if (seg) {
#pragma unroll
                for (int mi = 0; mi < 2; ++mi)
#pragma unroll
                    for (int i = 0; i < 16; ++i) { const int il = 32 * mi + crow(i, hh); const unsigned off = (unsigned)sRow[il] * 1024u + (unsigned)(512 + h * 128 + 32 * wave + r);
                        O[off] = f2bf(o[mi][i] * sRden[il]); }
            }
#pragma unroll
            for (int kt = 0; kt < 4; ++kt) for (int i = 0; i < 16; ++i) C[kt][i] *= cs;
#pragma unroll
            for (int ci = 0; ci < 2; ++ci)
#pragma unroll
                for (int s = 0; s < 2; ++s)
#pragma unroll
                    for (int kt = 0; kt < 4; ++kt) C[kt] = MFMA32(load_nat(sKT, STT, 32 * kt + r, 32 * ci + 16 * s + 8 * hh), vf[ci][s], C[kt]);
        }
    }
}

DI void ml_chain(const Params& p, unsigned char* smem, int dir, int b, int h) {
    if (__builtin_amdgcn_readfirstlane(threadIdx.x >> 6) < 4) ml_chain_role<true>(p, smem, dir, b, h); else ml_chain_role<false>(p, smem, dir, b, h);
}

DI void scan_phase(const Params& p, unsigned char* smem) {
    const int ch = blockIdx.x;
    if (ch < 256) {
        const int type = ch & 1, dir = (ch >> 1) & 1, h = (ch >> 2) & 3, b = ch >> 4;
#ifdef ONLY_DN
        dn_chain(p, smem, dir, b, h);
#elif defined(ONLY_ML)
        ml_chain(p, smem, dir, b, h);
#else
        if (type == 0) dn_chain(p, smem, dir, b, h); else ml_chain(p, smem, dir, b, h);
#endif
        __syncthreads();
    }
}

DI void finalize_phase(const Params& p) {
    const int wave = threadIdx.x >> 6, lane = threadIdx.x & 63;
    const int gw = blockIdx.x * 8 + wave, NGW = gridDim.x * 8;
    bf16_t* O0 = (bf16_t*)(p.ws + OFF_A); const bf16_t* O1 = O0 + (size_t)NLAT * 1024; const bf16_t* P = (const bf16_t*)(p.ws + OFF_P) + (size_t)MTOT * P1W;
    for (int row = gw; row < NLAT; row += NGW) {
#pragma unroll
        for (int part = 0; part < 2; ++part) {
            const int col = 512 * part + 8 * lane;
            const u32x4 a = *(const u32x4*)(O0 + (size_t)row * 1024 + col), bq = *(const u32x4*)(O1 + (size_t)row * 1024 + col);
            const u32x4 gt = *(const u32x4*)(P + (size_t)row * P2W + (part ? 2048 : 0) + 8 * lane);
            float o[8], g[8];
            o[0] = bflo(a.x) + bflo(bq.x); o[1] = bfhi(a.x) + bfhi(bq.x); o[2] = bflo(a.y) + bflo(bq.y); o[3] = bfhi(a.y) + bfhi(bq.y);
            o[4] = bflo(a.z) + bflo(bq.z); o[5] = bfhi(a.z) + bfhi(bq.z); o[6] = bflo(a.w) + bflo(bq.w); o[7] = bfhi(a.w) + bfhi(bq.w);
            g[0] = bflo(gt.x); g[1] = bfhi(gt.x); g[2] = bflo(gt.y); g[3] = bfhi(gt.y); g[4] = bflo(gt.z); g[5] = bfhi(gt.z); g[6] = bflo(gt.w); g[7] = bfhi(gt.w);
            float ss = 0.f;
#pragma unroll
            for (int e = 0; e < 8; ++e) ss += o[e] * o[e];
            ss += __shfl_xor(ss, 1); ss += __shfl_xor(ss, 2); ss += __shfl_xor(ss, 4); ss += __shfl_xor(ss, 8);
            const float rstd = rsqrtf(ss * (1.f / 128.f) + EPS);
            const float* nw = part ? p.ml_norm + 8 * lane : p.dn_norm + ((8 * lane) & 127);
            const f32x4 n0 = *(const f32x4*)nw, n1 = *(const f32x4*)(nw + 4);
            const float nn[8] = {n0.x, n0.y, n0.z, n0.w, n1.x, n1.y, n1.z, n1.w};
            float y[8];
#pragma unroll
            for (int e = 0; e < 8; ++e) y[e] = o[e] * rstd * nn[e] * (part ? sigmoidf_(g[e]) : siluf_(g[e]));
            u32x4 ov; ov.x = pk2(y[0], y[1]); ov.y = pk2(y[2], y[3]); ov.z = pk2(y[4], y[5]); ov.w = pk2(y[6], y[7]);
            *(u32x4*)(O0 + (size_t)row * 1024 + col) = ov;
        }
    }
}

constexpr int NPHASE = 11;
constexpr int LDS_BYTES = SCAN_LDS > pg8::STAGE_BYTES ? SCAN_LDS : pg8::STAGE_BYTES;

#ifndef REPEAT_MASK
#define REPEAT_MASK 0
#endif
template <int PH>
DI void run_phase(const Params& p, unsigned char* smem) {
    LAS unsigned char* lds = (LAS unsigned char*)smem;
    if constexpr (PH == 0) phase0(p, smem);
    if constexpr (PH == 1) norm_rows<0>(p);
    if constexpr (PH == 2) { pg8::Gemm g{(const bf16_t*)(p.ws + OFF_A), (const bf16_t*)(p.ws + OFF_WIN), MTOT, 4096, 1024};
                  pg8::StaticOrder S; S.init(g.M, g.N, gridDim.x, blockIdx.x);
                  pg8::EpiBf16 E{(bf16_t*)(p.ws + OFF_P), (bf16_t*)(p.ws + OFF_P) + (size_t)MTOT * P1W};
                  pg8::gemm_phase(lds, g, S, E);
                  gates_gemm(p); }
    if constexpr (PH == 3) dn_conv_phase(p, smem);
    if constexpr (PH == 4) scan_phase(p, smem);
    if constexpr (PH == 5) finalize_phase(p);
    if constexpr (PH == 6) { pg8::Gemm g{(const bf16_t*)(p.ws + OFF_A), (const bf16_t*)(p.ws + OFF_WOUT), NLAT, 1024, 1024};
                  pg8::StaticOrder S; S.init(g.M, g.N, gridDim.x, blockIdx.x);
                  pg8::EpiResB E{p.x, (bf16_t*)(p.ws + OFF_X1B), (const float*)(p.ws + OFF_MOD) + 2048};
                  pg8::gemm_phase(lds, g, S, E); }
    if constexpr (PH == 7) norm_rows_b(p);
    if constexpr (PH == 8) { pg8::Gemm g{(const bf16_t*)(p.ws + OFF_A) + (size_t)NLAT * 1024, (const bf16_t*)(p.ws + OFF_WFF1), NLAT, 5632, 1024};
                  pg8::StaticOrder S; S.init(g.M, g.N, gridDim.x, blockIdx.x);
                  pg8::EpiSwiglu E{(bf16_t*)(p.ws + OFF_P)};
                  pg8::gemm_phase(lds, g, S, E); }
    if constexpr (PH == 9) { pg8::Gemm g{(const bf16_t*)(p.ws + OFF_P), (const bf16_t*)(p.ws + OFF_WFF2), NLAT, 1024, DFF};
                  pg8::StaticOrder S; S.init(g.M, g.N, gridDim.x, blockIdx.x);
                  pg8::EpiResFromB E{(bf16_t*)(p.ws + OFF_X1B), (const float*)(p.ws + OFF_MOD) + 5120};
                  pg8::gemm_phase(lds, g, S, E); }
    if constexpr (PH == 10) final_norm_b(p);
}

#define XB_TMO      128
#define XB_XCNT(j)  (256  + 64 * (j))
#define XB_XSUB(j)  (1280 + 64 * (j))
#define XB_XGEN(j)  (2304 + 64 * (j))
#define XB_TOP      3328
#define XB_TOPGEN   3392
#define XCD_BAR_WORDS 3456
#define XB_SPIN_CAP (1u << 22)
DI unsigned xb_ld(unsigned* p)              { return __hip_atomic_load(p, __ATOMIC_RELAXED, __HIP_MEMORY_SCOPE_AGENT); }
DI unsigned xb_add(unsigned* p, unsigned v) { return __hip_atomic_fetch_add(p, v, __ATOMIC_RELAXED, __HIP_MEMORY_SCOPE_AGENT); }
DI unsigned xb_xcc_id() { return (unsigned)__builtin_amdgcn_s_getreg((3 << 11) | 20) & 0xFu; }
#define XB_SPIN(cond, bar) do { unsigned _sp = 0; while (cond) { __builtin_amdgcn_s_sleep(1); \
    if ((++_sp & 255u) == 0u) { if (xb_ld(&(bar)[XB_TMO])) break; if (_sp > XB_SPIN_CAP) { atomicAdd(&(bar)[XB_TMO], 1u); break; } } } } while (0)
struct XcdBarrier { unsigned* bar; unsigned x; volatile LAS unsigned* st; };
DI XcdBarrier xcd_barrier_post(unsigned* bar, volatile LAS unsigned* st) {
    XcdBarrier b; b.bar = bar; b.x = xb_xcc_id(); b.st = st;
    if (threadIdx.x == 0) (void)xb_add(&bar[XB_XCNT(b.x)], 1u);
    return b;
}
DI void xcd_barrier_complete(unsigned* bar, unsigned x, unsigned& nloc, unsigned& nx) {
    const unsigned G = gridDim.x * gridDim.y * gridDim.z;
    unsigned sum, cnt, mine, sp = 0u;
    for (;;) {
        sum = 0u; cnt = 0u; mine = 0u;
#pragma unroll
        for (unsigned j = 0; j < 16; ++j) { const unsigned c = xb_ld(&bar[XB_XCNT(j)]); sum += c; cnt += (c > 0u) ? 1u : 0u; mine = (j == x) ? c : mine; }
        if (sum == G) break;
        __builtin_amdgcn_s_sleep(1);
        if ((++sp & 255u) == 0u) { if (xb_ld(&bar[XB_TMO])) break; if (sp > XB_SPIN_CAP) { atomicAdd(&bar[XB_TMO], 1u); break; } }
    }
    nloc = mine > 0u ? mine : 1u; nx = cnt > 0u ? cnt : 1u;
}
DI void xcd_barrier(const XcdBarrier& b) {
    asm volatile("s_waitcnt vmcnt(0)" ::: "memory");
    __syncthreads();
    if (threadIdx.x == 0) {
        unsigned* bar = b.bar;
        __builtin_amdgcn_s_waitcnt(0);
        unsigned nloc = b.st[0], nx = b.st[1];
        if (nloc == 0u) { xcd_barrier_complete(bar, b.x, nloc, nx); b.st[0] = nloc; b.st[1] = nx; }
        const unsigned old = xb_add(&bar[XB_XSUB(b.x)], 1u);
        const unsigned gen = old / nloc;
        if (old + 1u == (gen + 1u) * nloc) {
            __builtin_amdgcn_fence(__ATOMIC_RELEASE, "agent");
            asm volatile("s_waitcnt vmcnt(0)" ::: "memory");
            const unsigned og = xb_add(&bar[XB_TOP], 1u);
            const unsigned tg = og / nx;
            if (og + 1u == (tg + 1u) * nx) xb_add(&bar[XB_TOPGEN], 1u);
            else XB_SPIN(xb_ld(&bar[XB_TOPGEN]) == tg, bar);
            __builtin_amdgcn_fence(__ATOMIC_ACQUIRE, "agent");
            xb_add(&bar[XB_XGEN(b.x)], 1u);
            asm volatile("s_waitcnt vmcnt(0)" ::: "memory");
        } else {
            XB_SPIN(xb_ld(&bar[XB_XGEN(b.x)]) == gen, bar);
            __builtin_amdgcn_fence(__ATOMIC_ACQUIRE, "agent");
            asm volatile("s_waitcnt vmcnt(0)" ::: "memory");
        }
    }
    __syncthreads();
}

__global__ void __launch_bounds__(512, 2) mega(Params p) {
    extern __shared__ __attribute__((aligned(16))) unsigned char smem[];
    unsigned* bar = (unsigned*)(p.ws + OFF_BAR);
    volatile LAS unsigned* st = (volatile LAS unsigned*)((LAS unsigned char*)smem + LDS_BYTES);
    if (threadIdx.x < 2) st[threadIdx.x] = 0u;
    __syncthreads();
    const XcdBarrier xb = xcd_barrier_post(bar, st);
#define SEAM(n) do { if ((n) == 0) cg::this_grid().sync(); else xcd_barrier(xb); } while (0)
#define PH(n) if (p.ph_lo <= (n) && (n) < p.ph_hi) { run_phase<n>(p, smem); \
        if ((REPEAT_MASK >> (n)) & 1) { SEAM(n); run_phase<n>(p, smem); } \
        if ((n) + 1 < p.ph_hi) SEAM(n); }
    PH(0) PH(1) PH(2) PH(3) PH(4) PH(5) PH(6) PH(7) PH(8) PH(9) PH(10)
#undef PH
#undef SEAM
}

extern "C" void kernel_launch(void* const* d_in, const int* in_sizes, int n_in, void* d_out, int out_size, void* d_ws, size_t ws_size, hipStream_t stream) {
    static int grid = 0;
    if (grid == 0) {
        if (n_in != 20 || out_size != NLAT * DM || ws_size < WS_END) { fprintf(stderr, "kernel_launch: unexpected shapes (n_in %d out %d ws %zu need %zu)\n", n_in, out_size, ws_size, (size_t)WS_END); grid = -1; return; }
        if (hipFuncSetAttribute((const void*)mega, hipFuncAttributeMaxDynamicSharedMemorySize, LDS_BYTES + 16) != hipSuccess) { fprintf(stderr, "hipFuncSetAttribute failed\n"); grid = -1; return; }
        int dev = 0, cus = 0, per_cu = 0;
        hipGetDevice(&dev); hipDeviceGetAttribute(&cus, hipDeviceAttributeMultiprocessorCount, dev);
        hipOccupancyMaxActiveBlocksPerMultiprocessor(&per_cu, (const void*)mega, 512, LDS_BYTES + 16);
        if (per_cu < 1) { fprintf(stderr, "occupancy query says %d blocks per CU\n", per_cu); per_cu = 1; }
        (void)hipGetLastError();
        grid = cus;
    }
    if (grid < 0) return;
    Params p{};
    const float** f = (const float**)&p;
    for (int i = 0; i < 20; ++i) f[i] = (const float*)d_in[i];
    p.out = (float*)d_out; p.ws = (unsigned char*)d_ws;
#if N_LAUNCH_PER_PHASE
    for (int ph = 0; ph < NPHASE; ++ph) {
        p.ph_lo = ph; p.ph_hi = ph + 1;
        hipLaunchKernelGGL(mega, dim3(grid), dim3(512), LDS_BYTES + 16, stream, p);
    }
#else
    p.ph_lo = 0; p.ph_hi = NPHASE;
    if (hipMemsetAsync((unsigned char*)d_ws + OFF_BAR, 0, XCD_BAR_WORDS * 4, stream) != hipSuccess) { fprintf(stderr, "memset of the barrier counter failed\n"); return; }
    void* args[] = {&p};
    hipError_t e = hipLaunchCooperativeKernel((const void*)mega, dim3(grid), dim3(512), args, LDS_BYTES + 16, stream);
    if (e != hipSuccess) fprintf(stderr, "cooperative launch failed: %s (grid %d)\n", hipGetErrorString(e), grid);
#endif
}
```
